# Optimizing an MI355X kernel written in HIP

```python
import math
import jax, jax.numpy as jnp
from jax import lax
import numpy as np

D_MODEL = 1024
BATCH = 8
SEQ = 2048
DEPTH = 2
DEC_BATCH = 128
DEC_SEQ = 4
PAST_LEN = 16384
PAGE_SIZE = 128

N_META = 16
D_MIX = 2 * D_MODEL
D_SSD = D_MIX // 2
D_LRU = D_MIX - D_SSD
SSD_HEAD_DIM = 64
SSD_HEADS = D_SSD // SSD_HEAD_DIM
SSD_GROUPS = 2
SSD_STATE = 128
SSD_CHUNK = 128
CONV_W = 4
SSD_CONV_DIM = D_SSD + 2 * SSD_GROUPS * SSD_STATE
LRU_BLOCKS = 16
LRU_BLOCK_W = D_LRU // LRU_BLOCKS
LRU_C = 8.0
D_FF = ((8 * D_MODEL // 3 + 127) // 128) * 128
IN_COLS = D_SSD + SSD_CONV_DIM + SSD_HEADS + 2 * D_LRU
EPS = 1e-6

kernel_name = "hymba_ssd_rglru_macaron_step"


def rmsnorm(x, g):
    xf = x.astype(jnp.float32)
    y = xf * lax.rsqrt(jnp.mean(xf * xf, axis=-1, keepdims=True) + EPS) * g.astype(jnp.float32)
    return y.astype(x.dtype)


def swiglu(x, wg, wu, wd):
    return (jax.nn.silu(x @ wg) * (x @ wu)) @ wd


def causal_conv(x, buf, w, b):
    L = x.shape[1]
    xp = jnp.concatenate([buf.astype(x.dtype), x], axis=1)
    y = b + sum(xp[:, k:k + L] * w[k] for k in range(CONV_W))
    return y, xp[:, -(CONV_W - 1):]


def ssd_segment(x, dt, a, bm, cm, h0, chunk):
    b, L, H, P = x.shape
    G, N = bm.shape[2], bm.shape[3]
    R = H // G
    c = L // chunk
    xc = x.astype(jnp.float32).reshape(b, c, chunk, G, R, P)
    dtc = dt.reshape(b, c, chunk, G, R)
    bc = bm.astype(jnp.float32).reshape(b, c, chunk, G, N)
    cc = cm.astype(jnp.float32).reshape(b, c, chunk, G, N)
    cum = jnp.cumsum(dtc * a.reshape(G, R), axis=2)
    diff = cum[:, :, :, None] - cum[:, :, None, :]
    mask = jnp.tril(jnp.ones((chunk, chunk), bool))[:, :, None, None]
    decay = jnp.exp(jnp.where(mask, diff, -jnp.inf))
    cb = jnp.einsum('bcign,bcjgn->bcijg', cc, bc)
    scores = cb[..., None] * decay * dtc[:, :, None]
    y_diag = jnp.einsum('bcijgr,bcjgrp->bcigrp', scores, xc)
    w_end = jnp.exp(cum[:, :, -1:] - cum) * dtc
    states = jnp.einsum('bcjgn,bcjgr,bcjgrp->bcgrpn', bc, w_end, xc)
    chunk_decay = jnp.exp(cum[:, :, -1])

    def step(h, inp):
        s, d = inp
        return d[..., None, None] * h + s, h

    h_final, h_prev = lax.scan(step, h0.astype(jnp.float32).reshape(b, G, R, P, N),
                               (jnp.moveaxis(states, 1, 0), jnp.moveaxis(chunk_decay, 1, 0)))
    h_prev = jnp.moveaxis(h_prev, 0, 1)
    y_off = jnp.einsum('bcign,bcgrpn,bcigr->bcigrp', cc, h_prev, jnp.exp(cum))
    y = (y_diag + y_off).reshape(b, L, H, P)
    return y, h_final.reshape(b, H, P, N)


def mixer(u, ssd_h, ssd_cbuf, lru_h, lru_cbuf, segments, p):
    b, L, _ = u.shape
    proj = u @ p['w_in']
    z, xbc, dt_raw, gate, xr = jnp.split(
        proj, [D_SSD, D_SSD + SSD_CONV_DIM, D_SSD + SSD_CONV_DIM + SSD_HEADS,
               D_SSD + SSD_CONV_DIM + SSD_HEADS + D_LRU], axis=-1)
    xbc_c, new_ssd_cbuf = causal_conv(xbc, ssd_cbuf, p['ssd_conv_w'], p['ssd_conv_b'])
    xbc_c = jax.nn.silu(xbc_c)
    xs, bm, cm = jnp.split(xbc_c, [D_SSD, D_SSD + SSD_GROUPS * SSD_STATE], axis=-1)
    dt = jax.nn.softplus(dt_raw.astype(jnp.float32) + p['ssd_dt_bias'].astype(jnp.float32))
    a = -jnp.exp(p['ssd_a_log'].astype(jnp.float32))
    xh = xs.reshape(b, L, SSD_HEADS, SSD_HEAD_DIM)
    bm = bm.reshape(b, L, SSD_GROUPS, SSD_STATE)
    cm = cm.reshape(b, L, SSD_GROUPS, SSD_STATE)
    h = ssd_h
    ys = []
    start = 0
    for length, chunk in segments:
        y_seg, h = ssd_segment(xh[:, start:start + length], dt[:, start:start + length], a,
                               bm[:, start:start + length], cm[:, start:start + length], h, chunk)
        ys.append(y_seg)
        start += length
    y = jnp.concatenate(ys, axis=1) if len(ys) > 1 else ys[0]
    y = y + p['ssd_d'].astype(jnp.float32)[:, None] * xh.astype(jnp.float32)
    y = y.reshape(b, L, D_SSD) * jax.nn.silu(z.astype(jnp.float32))
    y_ssd = rmsnorm(y, p['ssd_norm_g'])
    xr_c, new_lru_cbuf = causal_conv(xr, lru_cbuf, p['lru_conv_w'], p['lru_conv_b'])
    xb = xr_c.reshape(b, L, LRU_BLOCKS, LRU_BLOCK_W)
    r = jax.nn.sigmoid((jnp.einsum('blki,kij->blkj', xb, p['lru_wa']).reshape(b, L, D_LRU)
                        + p['lru_ba']).astype(jnp.float32))
    ig = jax.nn.sigmoid((jnp.einsum('blki,kij->blkj', xb, p['lru_wx']).reshape(b, L, D_LRU)
                         + p['lru_bx']).astype(jnp.float32))
    log_a = -LRU_C * r * jax.nn.softplus(-p['lru_lambda'].astype(jnp.float32))
    a_t = jnp.exp(log_a)
    mult = jnp.sqrt(-jnp.expm1(2.0 * log_a))
    bt = mult * ig * xr_c.astype(jnp.float32)
    bt = bt.at[:, 0].add(a_t[:, 0] * lru_h.astype(jnp.float32))

    def comb(left, right):
        a1, b1 = left
        a2, b2 = right
        return a1 * a2, a2 * b1 + b2

    _, h_all = lax.associative_scan(comb, (a_t, bt), axis=1)
    y_lru = h_all * jax.nn.gelu(gate.astype(jnp.float32))
    out = jnp.concatenate([y_ssd.astype(jnp.float32), y_lru], axis=-1).astype(u.dtype) @ p['w_out']
    return out, h, new_ssd_cbuf, h_all[:, -1], new_lru_cbuf


def trunk_layer(x, ssd_h, ssd_cbuf, lru_h, lru_cbuf, segments, p):
    x = x + 0.5 * rmsnorm(swiglu(rmsnorm(x, p['ffn1_pre_g']), p['ffn1_wg'], p['ffn1_wu'], p['ffn1_wd']),
                          p['ffn1_post_g'])
    m, ssd_h, ssd_cbuf, lru_h, lru_cbuf = mixer(rmsnorm(x, p['mix_pre_g']), ssd_h, ssd_cbuf, lru_h,
                                                lru_cbuf, segments, p)
    x = x + rmsnorm(m, p['mix_post_g'])
    x = x + 0.5 * rmsnorm(swiglu(rmsnorm(x, p['ffn2_pre_g']), p['ffn2_wg'], p['ffn2_wu'], p['ffn2_wd']),
                          p['ffn2_post_g'])
    return x, ssd_h, ssd_cbuf, lru_h, lru_cbuf


def setup_inputs(seed: int = 0) -> dict:
    key = jax.random.key(seed)
    ks = jax.random.split(key, 40)
    f32 = jnp.float32
    L = DEPTH

    def nrm(k, shape, scale):
        return jax.random.normal(k, shape, f32) * scale

    def gain(k, shape):
        return 1.0 + 0.05 * jax.random.normal(k, shape, f32)

    dt0 = jnp.exp(jax.random.uniform(ks[17], (L, SSD_HEADS), f32, math.log(1e-3), math.log(1e-1)))
    a0 = jax.random.uniform(ks[27], (L, D_LRU), f32, 0.9, 0.999)
    s0 = a0 ** (1.0 / LRU_C)
    return {
        "x_prompt": nrm(ks[0], (BATCH, SEQ, D_MODEL), 1.0),
        "x_sample": nrm(ks[1], (DEC_BATCH, DEC_SEQ, D_MODEL), 1.0),
        "state_ssd": nrm(ks[2], (L, DEC_BATCH, SSD_HEADS, SSD_HEAD_DIM, SSD_STATE), 0.1),
        "state_ssd_conv": nrm(ks[3], (L, DEC_BATCH, CONV_W - 1, SSD_CONV_DIM), 1.0),
        "state_lru": nrm(ks[4], (L, DEC_BATCH, D_LRU), 0.5),
        "state_lru_conv": nrm(ks[5], (L, DEC_BATCH, CONV_W - 1, D_LRU), 1.0),
        "meta_tokens": nrm(ks[6], (N_META, D_MODEL), 1.0),
        "ffn1_pre_g": gain(ks[7], (L, D_MODEL)),
        "ffn1_post_g": gain(ks[8], (L, D_MODEL)),
        "ffn1_wg": nrm(ks[9], (L, D_MODEL, D_FF), D_MODEL ** -0.5),
        "ffn1_wu": nrm(ks[10], (L, D_MODEL, D_FF), D_MODEL ** -0.5),
        "ffn1_wd": nrm(ks[11], (L, D_FF, D_MODEL), D_FF ** -0.5),
        "mix_pre_g": gain(ks[12], (L, D_MODEL)),
        "mix_post_g": gain(ks[13], (L, D_MODEL)),
        "w_in": nrm(ks[14], (L, D_MODEL, IN_COLS), D_MODEL ** -0.5),
        "ssd_conv_w": nrm(ks[15], (L, CONV_W, SSD_CONV_DIM), CONV_W ** -0.5),
        "ssd_conv_b": nrm(ks[16], (L, SSD_CONV_DIM), 0.01),
        "ssd_dt_bias": dt0 + jnp.log(-jnp.expm1(-dt0)),
        "ssd_a_log": jnp.log(jax.random.uniform(ks[18], (L, SSD_HEADS), f32, 1.0, 16.0)),
        "ssd_d": gain(ks[19], (L, SSD_HEADS)),
        "ssd_norm_g": gain(ks[20], (L, D_SSD)),
        "lru_conv_w": nrm(ks[21], (L, CONV_W, D_LRU), CONV_W ** -0.5),
        "lru_conv_b": nrm(ks[22], (L, D_LRU), 0.01),
        "lru_wa": nrm(ks[23], (L, LRU_BLOCKS, LRU_BLOCK_W, LRU_BLOCK_W), LRU_BLOCK_W ** -0.5),
        "lru_ba": nrm(ks[24], (L, D_LRU), 0.01),
        "lru_wx": nrm(ks[25], (L, LRU_BLOCKS, LRU_BLOCK_W, LRU_BLOCK_W), LRU_BLOCK_W ** -0.5),
        "lru_bx": nrm(ks[26], (L, D_LRU), 0.01),
        "lru_lambda": jnp.log(s0) - jnp.log1p(-s0),
        "w_out": nrm(ks[28], (L, D_MIX, D_MODEL), D_MIX ** -0.5),
        "ffn2_pre_g": gain(ks[29], (L, D_MODEL)),
        "ffn2_post_g": gain(ks[30], (L, D_MODEL)),
        "ffn2_wg": nrm(ks[31], (L, D_MODEL, D_FF), D_MODEL ** -0.5),
        "ffn2_wu": nrm(ks[32], (L, D_MODEL, D_FF), D_MODEL ** -0.5),
        "ffn2_wd": nrm(ks[33], (L, D_FF, D_MODEL), D_FF ** -0.5),
    }


def reference(x_prompt, x_sample, state_ssd, state_ssd_conv, state_lru, state_lru_conv, meta_tokens,
              ffn1_pre_g, ffn1_post_g, ffn1_wg, ffn1_wu, ffn1_wd, mix_pre_g, mix_post_g, w_in,
              ssd_conv_w, ssd_conv_b, ssd_dt_bias, ssd_a_log, ssd_d, ssd_norm_g, lru_conv_w, lru_conv_b,
              lru_wa, lru_ba, lru_wx, lru_bx, lru_lambda, w_out, ffn2_pre_g, ffn2_post_g, ffn2_wg,
              ffn2_wu, ffn2_wd):
    bp, seq, _ = x_prompt.shape
    bs, dec_seq, _ = x_sample.shape
    xp = jnp.concatenate([jnp.broadcast_to(meta_tokens.astype(x_prompt.dtype), (bp, N_META, D_MODEL)),
                          x_prompt], axis=1)
    prompt_segments = [(N_META, N_META), (seq, min(SSD_CHUNK, seq))]
    sample_segments = [(dec_seq, dec_seq)]
    xs = x_sample
    p_ssd, p_ssdc, p_lru, p_lruc = [], [], [], []
    s_ssd, s_ssdc, s_lru, s_lruc = [], [], [], []
    for l in range(DEPTH):
        p = dict(ffn1_pre_g=ffn1_pre_g[l], ffn1_post_g=ffn1_post_g[l], ffn1_wg=ffn1_wg[l],
                 ffn1_wu=ffn1_wu[l], ffn1_wd=ffn1_wd[l], mix_pre_g=mix_pre_g[l], mix_post_g=mix_post_g[l],
                 w_in=w_in[l], ssd_conv_w=ssd_conv_w[l], ssd_conv_b=ssd_conv_b[l],
                 ssd_dt_bias=ssd_dt_bias[l], ssd_a_log=ssd_a_log[l], ssd_d=ssd_d[l],
                 ssd_norm_g=ssd_norm_g[l], lru_conv_w=lru_conv_w[l], lru_conv_b=lru_conv_b[l],
                 lru_wa=lru_wa[l], lru_ba=lru_ba[l], lru_wx=lru_wx[l], lru_bx=lru_bx[l],
                 lru_lambda=lru_lambda[l], w_out=w_out[l], ffn2_pre_g=ffn2_pre_g[l],
                 ffn2_post_g=ffn2_post_g[l], ffn2_wg=ffn2_wg[l], ffn2_wu=ffn2_wu[l], ffn2_wd=ffn2_wd[l])
        xp, h1, c1, h2, c2 = trunk_layer(
            xp,
            jnp.zeros((bp, SSD_HEADS, SSD_HEAD_DIM, SSD_STATE), jnp.float32),
            jnp.zeros((bp, CONV_W - 1, SSD_CONV_DIM), xp.dtype),
            jnp.zeros((bp, D_LRU), jnp.float32),
            jnp.zeros((bp, CONV_W - 1, D_LRU), xp.dtype),
            prompt_segments, p)
        p_ssd.append(h1); p_ssdc.append(c1); p_lru.append(h2); p_lruc.append(c2)
        xs, h1, c1, h2, c2 = trunk_layer(xs, state_ssd[l], state_ssd_conv[l], state_lru[l],
                                         state_lru_conv[l], sample_segments, p)
        s_ssd.append(h1); s_ssdc.append(c1); s_lru.append(h2); s_lruc.append(c2)
    y_prompt = xp[:, N_META:]
    return (y_prompt, xs,
            jnp.stack(p_ssd), jnp.stack(p_ssdc), jnp.stack(p_lru), jnp.stack(p_lruc),
            jnp.stack(s_ssd), jnp.stack(s_ssdc), jnp.stack(s_lru), jnp.stack(s_lruc))
```

```cpp
#include <hip/hip_runtime.h>
#include <hip/hip_cooperative_groups.h>
#include <cstdio>
#include <cstdint>
namespace cg = cooperative_groups;

#ifndef MEGA
#define MEGA 1
#endif

constexpr int D = 1024, DFF = 2816, NGU = 2 * DFF, NIN = 4608, DMIX = 2048, XBCW = 1536, INCOLS = 4624, DEPTH = 2;
constexpr int NPB = 8, SEQ = 2048, NSB = 128, NMETA = 16;
constexpr int ROW_S = 16384, ROW_M = 16896, NROWS = 16912, MP = 17152;
constexpr int PZ = 0, PX = 1024, PB = 2048, PC = 2304, PGATE = 2560, PXR = 3584;
constexpr float EPS = 1e-6f;
constexpr size_t O_YP = 0, O_YS = 16777216, O_SSDP = 17301504, O_CONVP = 19398656, O_LRUP = 19472384, O_LCONVP = 19488768, O_SSDS = 19537920, O_CONVS = 53092352, O_LRUS = 54272000, O_LCONVS = 54534144, O_END = 55320576;
enum { I_XP = 0, I_XS, I_SSD, I_SSDCONV, I_LRU, I_LRUCONV, I_META, I_F1PRE, I_F1POST, I_F1WG, I_F1WU, I_F1WD, I_MPRE, I_MPOST, I_WIN, I_CONVW, I_CONVB, I_DTB, I_ALOG, I_SSDD, I_SSDG,
       I_LCONVW, I_LCONVB, I_LWA, I_LBA, I_LWX, I_LBX, I_LLAM, I_WOUT, I_F2PRE, I_F2POST, I_F2WG, I_F2WU, I_F2WD, N_IN };
constexpr size_t MiB = 1u << 20;
constexpr size_t WS_CTL = 0, CTL_ZERO_BYTES = 1 * MiB;
constexpr size_t WS_WGU1 = 2 * MiB, WS_WD1 = 24 * MiB, WS_WIN = 35 * MiB, WS_WOUT = 53 * MiB, WS_WGU2 = 61 * MiB, WS_WD2 = 83 * MiB, WS_WDT = 94 * MiB;
constexpr size_t SZ_WGU = (size_t)NGU * D * 2, SZ_WD = (size_t)D * DFF * 2, SZ_WIN = (size_t)NIN * D * 2, SZ_WOUT = (size_t)D * DMIX * 2, SZ_WDT = 16 * D * 4;
constexpr size_t WS_XB = 95 * MiB, WS_X = 129 * MiB, WS_Y = 196 * MiB, WS_H = 263 * MiB, WS_PROJ = 356 * MiB, WS_XBCC = 507 * MiB, WS_DT = 558 * MiB, WS_YMIX = 560 * MiB, WS_END = 627 * MiB;
static_assert(WS_WGU1 + 2 * SZ_WGU <= WS_WD1 && WS_WD1 + 2 * SZ_WD <= WS_WIN && WS_WIN + 2 * SZ_WIN <= WS_WOUT && WS_WOUT + 2 * SZ_WOUT <= WS_WGU2 && WS_WGU2 + 2 * SZ_WGU <= WS_WD2 && WS_WD2 + 2 * SZ_WD <= WS_WDT && WS_WDT + 2 * SZ_WDT <= WS_XB, "weights map");
static_assert(WS_XB + (size_t)MP * D * 2 <= WS_X && WS_X + (size_t)MP * D * 4 <= WS_Y && WS_Y + (size_t)MP * D * 4 <= WS_H && WS_H + (size_t)MP * DFF * 2 <= WS_PROJ && WS_PROJ + (size_t)MP * NIN * 2 <= WS_XBCC &&
              WS_XBCC + (size_t)MP * XBCW * 2 <= WS_DT && WS_DT + (size_t)MP * 16 * 4 <= WS_YMIX && WS_YMIX + (size_t)MP * DMIX * 2 <= WS_END, "activation map");
constexpr int CW_BAR = 4096, CW_SSQ = 65536;
static_assert((size_t)(CW_SSQ + 2 * MP) * 4 <= CTL_ZERO_BYTES, "ctl map");
constexpr int RING_BYTES = 131072, MISC_OFF = RING_BYTES + 320, LDS_BYTES = 147456;
constexpr int NWAVES = 8, NTHR = 512;
namespace pg8 {
#define PG8_LAS __attribute__((address_space(3)))
typedef unsigned short bf16_t;
typedef short bf16x8 __attribute__((ext_vector_type(8)));
typedef float f32x4 __attribute__((ext_vector_type(4)));
typedef unsigned u32x4 __attribute__((ext_vector_type(4)));
constexpr int BM = 256, BK = 64, HALF = 128, HTB = HALF * BK * 2  , STAGE_BYTES = 8 * HTB, NXCD = 8, WGM = 8;

__host__ __device__ __forceinline__ int lds_byte(int r, int c) { const int st = (r >> 4) * 2 + (c >> 5), rr = r & 15, cc = c & 31, ob = rr * 64 + cc * 2; return st * 1024 + (ob ^ (((ob >> 9) & 1) << 5)); }
__host__ __device__ __forceinline__ void stage_rc(int b, int& R, int& C) { const int st = b / 1024, sb = b % 1024, swz = sb ^ (((sb >> 9) & 1) << 5); R = (st >> 1) * 16 + swz / 64; C = (st & 1) * 32 + (swz % 64) / 2; }
__host__ __device__ __forceinline__ int perm32(int rho) { const int n = rho >> 4, i = rho & 15; return 8 * (i >> 2) + 4 * n + (i & 3); }

struct Unit { int pm, pn; };
struct Gemm { const bf16_t* A; const bf16_t* Bt; int M, N, K; };

struct StaticOrder {
    int nM, nN, nwg, G, c;
    __host__ __device__ void init(int M, int N, int G_, int c_) { nM = M / BM; nN = N / BM; nwg = nM * nN; G = G_; c = c_; }
    __host__ __device__ bool next(int i, Unit& u) const {
        const long L = (long)i * G + c; if (L >= nwg) return false;
        int wgid = (int)L; { const int q = nwg / NXCD, r = nwg % NXCD, xcd = wgid % NXCD, off = wgid / NXCD; wgid = (xcd < r ? xcd * (q + 1) : r * (q + 1) + (xcd - r) * q) + off; }
        const int nig = WGM * nN, gid = wgid / nig, fm = gid * WGM, gsz = (nM - fm) < WGM ? (nM - fm) : WGM;
        u.pm = fm + ((wgid % nig) % gsz); u.pn = (wgid % nig) / gsz; return true;
    }
    __device__ __forceinline__ void a_ready(const Unit&) const {}
    __device__ __forceinline__ void done(const Unit&) const {}
};
__device__ __forceinline__ unsigned cvt_pk_bf16(float lo, float hi) { unsigned r; asm volatile("v_cvt_pk_bf16_f32 %0, %1, %2" : "=v"(r) : "v"(lo), "v"(hi)); return r; }
typedef unsigned u32x2 __attribute__((ext_vector_type(2)));
struct EpiF32 {
    static constexpr bool PERM = false, AFTER_DRAIN = false;
    float* C; int ldc;
    __device__ __forceinline__ void operator()(const f32x4 (&acc)[2][2][4][2], const Unit& u, int wr, int wc, int fr, int fq) const {
        const int row0 = u.pm * BM + wr * 64 + fr, col0 = u.pn * BM + wc * 32 + 4 * fq;
#pragma unroll
        for (int ai = 0; ai < 2; ++ai)
#pragma unroll
            for (int m = 0; m < 4; ++m) { float* rowp = C + (size_t)(row0 + ai * HALF + m * 16) * ldc + col0;
#pragma unroll
                for (int bj = 0; bj < 2; ++bj)
#pragma unroll
                    for (int n = 0; n < 2; ++n) *(f32x4*)(rowp + bj * HALF + n * 16) = acc[ai][bj][m][n]; }
    }
};
struct EpiBf16P {
    static constexpr bool PERM = true, AFTER_DRAIN = false;
    bf16_t* O; int ldc;
    __device__ __forceinline__ void operator()(const f32x4 (&acc)[2][2][4][2], const Unit& u, int wr, int wc, int fr, int fq) const {
        const int row0 = u.pm * BM + wr * 64 + fr, col0 = u.pn * BM + wc * 32 + 8 * fq;
#pragma unroll
        for (int ai = 0; ai < 2; ++ai)
#pragma unroll
            for (int m = 0; m < 4; ++m) { bf16_t* rowp = O + (size_t)(row0 + ai * HALF + m * 16) * ldc + col0;
#pragma unroll
                for (int bj = 0; bj < 2; ++bj) { const f32x4 v0 = acc[ai][bj][m][0], v1 = acc[ai][bj][m][1];
                    u32x4 w; w.x = cvt_pk_bf16(v0[0], v0[1]); w.y = cvt_pk_bf16(v0[2], v0[3]); w.z = cvt_pk_bf16(v1[0], v1[1]); w.w = cvt_pk_bf16(v1[2], v1[3]);
                    *(u32x4*)(rowp + bj * HALF) = w; } }
    }
};
struct EpiSwiGLU {
    static constexpr bool PERM = false, AFTER_DRAIN = false;
    bf16_t* Hb; int ldh;
    __device__ __forceinline__ void operator()(const f32x4 (&acc)[2][2][4][2], const Unit& u, int wr, int wc, int fr, int fq) const {
        const int row0 = u.pm * BM + wr * 64 + fr;
#pragma unroll
        for (int ai = 0; ai < 2; ++ai)
#pragma unroll
            for (int m = 0; m < 4; ++m) { bf16_t* rowp = Hb + (size_t)(row0 + ai * HALF + m * 16) * ldh;
#pragma unroll
                for (int bj = 0; bj < 2; ++bj) { const int grp = u.pn * 8 + bj * 4 + wc; const f32x4 g = acc[ai][bj][m][0], up = acc[ai][bj][m][1]; float h[4];
#pragma unroll
                    for (int j = 0; j < 4; ++j) h[j] = g[j] * __builtin_amdgcn_rcpf(1.0f + __expf(-g[j])) * up[j];
                    u32x2 w; w.x = cvt_pk_bf16(h[0], h[1]); w.y = cvt_pk_bf16(h[2], h[3]);
                    *(u32x2*)(rowp + grp * 16 + 4 * fq) = w; } }
    }
};

struct EpiAny {
    static constexpr bool AFTER_DRAIN = false;
    int kind; bool perm; void* out; int ld;
    __device__ __forceinline__ void operator()(const f32x4 (&acc)[2][2][4][2], const Unit& u, int wr, int wc, int fr, int fq) const {
        if (kind == 0) { EpiF32 e{(float*)out, ld}; e(acc, u, wr, wc, fr, fq); }
        else if (kind == 1) { EpiBf16P e{(bf16_t*)out, ld}; e(acc, u, wr, wc, fr, fq); }
        else { EpiSwiGLU e{(bf16_t*)out, ld}; e(acc, u, wr, wc, fr, fq); }
    }
};
template <class Epi, class Sched, bool ALIGN_EPI = false, bool SP2 = false>
__device__ __forceinline__ void gemm_phase(PG8_LAS unsigned char* lds, const Gemm g, const Sched& S, const Epi& E) {
    const int tid = threadIdx.x, wid = __builtin_amdgcn_readfirstlane(tid >> 6), lane = tid & 63, wr = wid >> 2, wc = wid & 3, fr = lane & 15, fq = lane >> 4;
    const int K = g.K, nt = K / BK;
    unsigned voffA[2], voffB[2];
#pragma unroll
    for (int i = 0; i < 2; ++i) { int R, C; stage_rc(tid * 16 + i * 8192, R, C); const int Rb = E.perm ? ((R & ~31) + perm32(R & 31)) : R;
        voffA[i] = (unsigned)(R * K + C) * 2u; voffB[i] = (unsigned)(Rb * K + C) * 2u; }
    const size_t kstep = (size_t)(BK * 2);
    const size_t hstep = (size_t)HALF * K * 2;
    const size_t tstep = 2 * hstep;
    const unsigned ldsw = (unsigned)wid * 1024u;
    const int aoff = lds_byte(wr * 64 + fr, fq * 8), boff = lds_byte(wc * 32 + fr, fq * 8);
#define PG8_SA(b, h) (((b) * 2 + (h)) * HTB)
#define PG8_SB(b, h) ((4 + (b) * 2 + (h)) * HTB)
#define PG8_STAGE(bufoff, gbase, voff) do { _Pragma("unroll") for (int _i = 0; _i < 2; ++_i) \
        __builtin_amdgcn_global_load_lds((const unsigned*)((const char*)(gbase) + (voff)[_i]), (PG8_LAS unsigned*)(lds + (bufoff) + ldsw + _i * 8192), 16, 0, 0); } while (0)
#define PG8_LDA(dst, b, h) do { _Pragma("unroll") for (int m = 0; m < 4; ++m) _Pragma("unroll") for (int k = 0; k < 2; ++k) dst[m][k] = *(const PG8_LAS bf16x8*)(lds + PG8_SA(b, h) + aoff + m * 2048 + k * 1024); } while (0)
#define PG8_LDB(dst, b, h) do { _Pragma("unroll") for (int n = 0; n < 2; ++n) _Pragma("unroll") for (int k = 0; k < 2; ++k) dst[n][k] = *(const PG8_LAS bf16x8*)(lds + PG8_SB(b, h) + boff + n * 2048 + k * 1024); } while (0)
#define PG8_MMA(ai, bj, At, Bt) do { __builtin_amdgcn_s_setprio(1); _Pragma("unroll") for (int m = 0; m < 4; ++m) _Pragma("unroll") for (int n = 0; n < 2; ++n) _Pragma("unroll") for (int k = 0; k < 2; ++k) \
        acc[ai][bj][m][n] = __builtin_amdgcn_mfma_f32_16x16x32_bf16(Bt[n][k], At[m][k], acc[ai][bj][m][n], 0, 0, 0); __builtin_amdgcn_s_setprio(0); } while (0)
#define PG8_WAIT_V(n) asm volatile("s_waitcnt vmcnt(" #n ")" ::: "memory")
#define PG8_WAIT_L(n) asm volatile("s_waitcnt lgkmcnt(" #n ")" ::: "memory")
#define PG8_BAR __builtin_amdgcn_s_barrier()
#define PG8_SCHED __builtin_amdgcn_sched_barrier(0)
    Unit cur, nxt; int ui = 0;
    if (!S.next(0, cur)) return;
    f32x4 acc[2][2][4][2];
#pragma unroll
    for (int a = 0; a < 2; ++a)
#pragma unroll
        for (int b = 0; b < 2; ++b)
#pragma unroll
            for (int m = 0; m < 4; ++m)
#pragma unroll
                for (int n = 0; n < 2; ++n) acc[a][b][m][n] = (f32x4){0.f, 0.f, 0.f, 0.f};
    bf16x8 At[4][2], B0[2][2], B1[2][2];
    const char* cA = (const char*)g.A + (size_t)cur.pm * tstep; const char* cB = (const char*)g.Bt + (size_t)cur.pn * tstep;
    S.a_ready(cur);
    if constexpr (SP2) {
        PG8_STAGE(PG8_SB(0, 0), cB, voffB); PG8_STAGE(PG8_SB(0, 1), cB + hstep, voffB); PG8_STAGE(PG8_SA(0, 0), cA, voffA); PG8_STAGE(PG8_SA(0, 1), cA + hstep, voffA);
        if (wr == 1) PG8_BAR;
        PG8_WAIT_V(2); PG8_BAR;
        PG8_STAGE(PG8_SB(1, 0), cB + kstep, voffB); PG8_STAGE(PG8_SA(1, 0), cA + kstep, voffA); PG8_STAGE(PG8_SB(1, 1), cB + hstep + kstep, voffB);
        PG8_WAIT_V(6); PG8_BAR;
    } else {
        PG8_STAGE(PG8_SB(0, 0), cB, voffB); PG8_STAGE(PG8_SA(0, 0), cA, voffA); PG8_STAGE(PG8_SB(0, 1), cB + hstep, voffB); PG8_STAGE(PG8_SA(0, 1), cA + hstep, voffA);
        if (wr == 1) PG8_BAR;
        PG8_WAIT_V(4); PG8_BAR;
        PG8_STAGE(PG8_SB(1, 0), cB + kstep, voffB); PG8_STAGE(PG8_SA(1, 0), cA + kstep, voffA); PG8_STAGE(PG8_SB(1, 1), cB + hstep + kstep, voffB);
        PG8_WAIT_V(6); PG8_BAR;
    }
    for (;;) {
        const bool has_next = S.next(ui + 1, nxt);
        const char* nA = has_next ? (const char*)g.A + (size_t)nxt.pm * tstep : cA; const char* nB = has_next ? (const char*)g.Bt + (size_t)nxt.pn * tstep : cB;
        for (int t = 0; t < nt; t += 2) {
            const bool last = (t == nt - 2);
            const char* a1 = cA + (size_t)(t + 1) * kstep;
            const char* a2 = last ? nA : cA + (size_t)(t + 2) * kstep; const char* b2 = last ? nB : cB + (size_t)(t + 2) * kstep;
            const char* a3 = a2 + kstep; const char* b3 = b2 + kstep;
            if (last && has_next) S.a_ready(nxt);
            if constexpr (SP2) {
            PG8_LDB(B0, 0, 0); PG8_LDB(B1, 0, 1); PG8_SCHED; PG8_LDA(At, 0, 0); PG8_STAGE(PG8_SA(1, 1), a1 + hstep, voffA);
            PG8_WAIT_V(8); PG8_WAIT_L(0); PG8_BAR; PG8_MMA(0, 0, At, B0); PG8_MMA(0, 1, At, B1); PG8_BAR; PG8_SCHED;
            PG8_LDA(At, 0, 1); PG8_STAGE(PG8_SB(0, 0), b2, voffB); PG8_STAGE(PG8_SB(0, 1), b2 + hstep, voffB); PG8_STAGE(PG8_SA(0, 0), a2, voffA);
            PG8_WAIT_V(8); PG8_WAIT_L(0); PG8_BAR; PG8_MMA(1, 0, At, B0); PG8_MMA(1, 1, At, B1); PG8_BAR; PG8_SCHED;
            PG8_LDB(B0, 1, 0); PG8_LDB(B1, 1, 1); PG8_SCHED; PG8_LDA(At, 1, 0); PG8_STAGE(PG8_SA(0, 1), a2 + hstep, voffA);
            PG8_WAIT_V(8); PG8_WAIT_L(0); PG8_BAR; PG8_MMA(0, 0, At, B0); PG8_MMA(0, 1, At, B1); PG8_BAR; PG8_SCHED;
            PG8_LDA(At, 1, 1); PG8_STAGE(PG8_SB(1, 0), b3, voffB); PG8_STAGE(PG8_SB(1, 1), b3 + hstep, voffB); PG8_STAGE(PG8_SA(1, 0), a3, voffA);
            PG8_WAIT_V(8); PG8_WAIT_L(0); PG8_BAR; PG8_MMA(1, 0, At, B0); PG8_MMA(1, 1, At, B1); PG8_BAR; PG8_SCHED;
            } else {
            PG8_LDB(B0, 0, 0); PG8_SCHED; PG8_LDA(At, 0, 0); PG8_STAGE(PG8_SA(1, 1), a1 + hstep, voffA);
            PG8_WAIT_L(8); PG8_BAR; PG8_WAIT_L(0); PG8_MMA(0, 0, At, B0); PG8_BAR; PG8_SCHED;
            PG8_LDB(B1, 0, 1); PG8_STAGE(PG8_SB(0, 0), b2, voffB);
            PG8_BAR; PG8_WAIT_L(0); PG8_MMA(0, 1, At, B1); PG8_BAR;
            PG8_LDA(At, 0, 1); PG8_STAGE(PG8_SA(0, 0), a2, voffA);
            PG8_BAR; PG8_WAIT_L(0); PG8_MMA(1, 0, At, B0); PG8_BAR; PG8_SCHED;
            PG8_STAGE(PG8_SB(0, 1), b2 + hstep, voffB);
            PG8_WAIT_V(6); PG8_BAR; PG8_MMA(1, 1, At, B1); PG8_BAR;
            PG8_LDB(B0, 1, 0); PG8_SCHED; PG8_LDA(At, 1, 0); PG8_STAGE(PG8_SA(0, 1), a2 + hstep, voffA);
            PG8_WAIT_L(8); PG8_BAR; PG8_WAIT_L(0); PG8_MMA(0, 0, At, B0); PG8_BAR; PG8_SCHED;
            PG8_LDB(B1, 1, 1); PG8_STAGE(PG8_SB(1, 0), b3, voffB);
            PG8_BAR; PG8_WAIT_L(0); PG8_MMA(0, 1, At, B1); PG8_BAR;
            PG8_LDA(At, 1, 1); PG8_STAGE(PG8_SA(1, 0), a3, voffA);
            PG8_BAR; PG8_WAIT_L(0); PG8_MMA(1, 0, At, B0); PG8_BAR; PG8_SCHED;
            PG8_STAGE(PG8_SB(1, 1), b3 + hstep, voffB);
            PG8_WAIT_V(6); PG8_BAR; PG8_MMA(1, 1, At, B1); PG8_BAR;
            }
        }
        if constexpr (ALIGN_EPI) { if (wr == 0) PG8_BAR; }
        if constexpr (!Epi::AFTER_DRAIN) { E(acc, cur, wr, wc, fr, fq); S.done(cur); }
        if (!has_next) break;
#pragma unroll
        for (int a = 0; a < 2; ++a)
#pragma unroll
            for (int b = 0; b < 2; ++b)
#pragma unroll
                for (int m = 0; m < 4; ++m)
#pragma unroll
                    for (int n = 0; n < 2; ++n) acc[a][b][m][n] = (f32x4){0.f, 0.f, 0.f, 0.f};
        cur = nxt; cA = nA; cB = nB; ++ui;
        if constexpr (ALIGN_EPI) { if (wr == 1) PG8_BAR; }
    }
    PG8_WAIT_V(0);
    if constexpr (!ALIGN_EPI) { if (wr == 0) PG8_BAR; }
    PG8_BAR;
    if constexpr (Epi::AFTER_DRAIN) { E.fused(acc, cur, wr, wc, fr, fq, lds, wid, lane); S.done(cur); }
#undef PG8_SA
#undef PG8_SB
#undef PG8_STAGE
#undef PG8_LDA
#undef PG8_LDB
#undef PG8_MMA
#undef PG8_WAIT_V
#undef PG8_WAIT_L
#undef PG8_BAR
#undef PG8_SCHED
}
}

#define GAS __attribute__((address_space(1)))
#define LAS __attribute__((address_space(3)))
typedef unsigned short bf16;
typedef unsigned v4u __attribute__((ext_vector_type(4)));
typedef unsigned v2u __attribute__((ext_vector_type(2)));
typedef float f32x4 __attribute__((ext_vector_type(4)));
typedef GAS unsigned gu32;
#define LDS_WAIT() asm volatile("s_waitcnt lgkmcnt(0)" ::: "memory")
#define VM_WAIT() asm volatile("s_waitcnt vmcnt(0)" ::: "memory")
__device__ __forceinline__ unsigned f2bf(float f) { unsigned u = __builtin_bit_cast(unsigned, f); return (u + 0x7fffu + ((u >> 16) & 1u)) >> 16; }
__device__ __forceinline__ unsigned pk2(float lo, float hi) { return f2bf(lo) | (f2bf(hi) << 16); }
__device__ __forceinline__ float bf2f(unsigned short b) { return __builtin_bit_cast(float, (unsigned)b << 16); }
__device__ __forceinline__ float bflo(unsigned w) { return __builtin_bit_cast(float, w << 16); }
__device__ __forceinline__ float bfhi(unsigned w) { return __builtin_bit_cast(float, w & 0xffff0000u); }
__device__ __forceinline__ float wave_sum(float v) {
#pragma unroll
    for (int o = 1; o < 64; o <<= 1) v += __shfl_xor(v, o);
    return v;
}
__device__ __forceinline__ float silu_f(float x) { return x * __builtin_amdgcn_rcpf(1.0f + __expf(-x)); }
__device__ __forceinline__ float sigmoid_f(float x) { return __builtin_amdgcn_rcpf(1.0f + __expf(-x)); }
__device__ __forceinline__ float softplus_f(float z) { return z > 0.f ? z + log1pf(expf(-z)) : log1pf(expf(z)); }
__device__ __forceinline__ float gelu_tanh_f(float x) { const float u = 0.7978845608028654f * (x + 0.044715f * x * x * x); const float t = 1.0f - 2.0f * __builtin_amdgcn_rcpf(__expf(2.0f * u) + 1.0f); return 0.5f * x * (1.0f + t); }

#define XB_TMO      128
#define XB_XCNT(j)  (256  + 64 * (j))
#define XB_XSUB(j)  (1280 + 64 * (j))
#define XB_XGEN(j)  (2304 + 64 * (j))
#define XB_TOP      3328
#define XB_TOPGEN   3392
#define XCD_BAR_WORDS 3456
#define XB_SPIN_CAP (1u << 18)

__device__ __forceinline__ unsigned xb_ld(unsigned* p)              { return __hip_atomic_load(p, __ATOMIC_RELAXED, __HIP_MEMORY_SCOPE_AGENT); }
__device__ __forceinline__ unsigned xb_add(unsigned* p, unsigned v) { return __hip_atomic_fetch_add(p, v, __ATOMIC_RELAXED, __HIP_MEMORY_SCOPE_AGENT); }
__device__ __forceinline__ unsigned xb_xcc_id() { return (unsigned)__builtin_amdgcn_s_getreg((3 << 11) | 20) & 0xFu; }
#define XB_SPIN(cond, bar) do { unsigned _sp = 0; while (cond) { __builtin_amdgcn_s_sleep(1); \
    if ((++_sp & 255u) == 0u) { if (xb_ld(&(bar)[XB_TMO])) break; if (_sp > XB_SPIN_CAP) { atomicAdd(&(bar)[XB_TMO], 1u); break; } } } } while (0)

struct XcdBarrier {
    unsigned* bar; unsigned x;
    volatile LAS unsigned* st;
};

__device__ __forceinline__ XcdBarrier xcd_barrier_post(unsigned* bar, volatile LAS unsigned* st) {
    XcdBarrier b; b.bar = bar; b.x = xb_xcc_id(); b.st = st;
    if (threadIdx.x == 0) (void)xb_add(&bar[XB_XCNT(b.x)], 1u);
    return b;
}
__device__ __forceinline__ void xcd_barrier_complete(unsigned* bar, unsigned x, unsigned& nloc, unsigned& nx) {
    const unsigned G = gridDim.x * gridDim.y * gridDim.z;
    unsigned sum, cnt, mine, sp = 0u;
    for (;;) {
        sum = 0u; cnt = 0u; mine = 0u;
#pragma unroll
        for (unsigned j = 0; j < 16; ++j) { const unsigned c = xb_ld(&bar[XB_XCNT(j)]); sum += c; cnt += (c > 0u) ? 1u : 0u; mine = (j == x) ? c : mine; }
        if (sum == G) break;
        __builtin_amdgcn_s_sleep(1);
        if ((++sp & 255u) == 0u) { if (xb_ld(&bar[XB_TMO])) break; if (sp > XB_SPIN_CAP) { atomicAdd(&bar[XB_TMO], 1u); break; } }
    }
    nloc = mine > 0u ? mine : 1u; nx = cnt > 0u ? cnt : 1u;
}

__device__ __forceinline__ void xcd_barrier(const XcdBarrier& b) {
    asm volatile("s_waitcnt vmcnt(0)" ::: "memory");
    __syncthreads();
    if (threadIdx.x == 0) {
        unsigned* bar = b.bar;
        __builtin_amdgcn_s_waitcnt(0);
        unsigned nloc = b.st[0], nx = b.st[1];
        if (nloc == 0u) { xcd_barrier_complete(bar, b.x, nloc, nx); b.st[0] = nloc; b.st[1] = nx; }
        const unsigned old = xb_add(&bar[XB_XSUB(b.x)], 1u);
        const unsigned gen = old / nloc;
        if (old + 1u == (gen + 1u) * nloc) {
            __builtin_amdgcn_fence(__ATOMIC_RELEASE, "agent");
            asm volatile("s_waitcnt vmcnt(0)" ::: "memory");
            const unsigned og = xb_add(&bar[XB_TOP], 1u);
            const unsigned tg = og / nx;
            if (og + 1u == (tg + 1u) * nx) xb_add(&bar[XB_TOPGEN], 1u);
            else XB_SPIN(xb_ld(&bar[XB_TOPGEN]) == tg, bar);
            __builtin_amdgcn_fence(__ATOMIC_ACQUIRE, "agent");
            xb_add(&bar[XB_XGEN(b.x)], 1u);
            asm volatile("s_waitcnt vmcnt(0)" ::: "memory");
        } else {
            XB_SPIN(xb_ld(&bar[XB_XGEN(b.x)]) == gen, bar);
            __builtin_amdgcn_fence(__ATOMIC_ACQUIRE, "agent");
            asm volatile("s_waitcnt vmcnt(0)" ::: "memory");
        }
    }
    __syncthreads();
}

struct Params { const float* in[N_IN]; float* out; unsigned char* ws; int ph_lo, ph_hi; };
#define WSP(T, off) ((T*)(P.ws + (off)))
struct Ctx {
    LAS unsigned char* lds; int tid, lane, wave, G, gw, NGW;
};
__device__ __forceinline__ int prow(int b, int tt) { return tt < NMETA ? ROW_M + tt : b * SEQ + tt - NMETA; }

template <int MODE> __device__ __forceinline__ int dest_row(int n) {
    if (MODE == 1) return (n >> 4) * 32 + (n & 15);
    if (MODE == 2) return (n >> 4) * 32 + 16 + (n & 15);
    if (MODE == 3) return n < 2560 ? n : (n < 2576 ? -1 : n - 16);
    return n;
}
template <int MODE> __device__ __forceinline__ void transpose_item(const float* W, int K, int N, const float* gk, int gsplit, bf16* WT, LAS float* scr, int item, int lane) {
    const int nblk = (N + 31) / 32, kb = item / nblk, nb = item % nblk, k0 = 64 * kb, n0 = 32 * nb;
    const int col = n0 + (lane & 31);
#pragma unroll 8
    for (int i = 0; i < 32; ++i) { const int kk = 2 * i + (lane >> 5); const int k = k0 + kk;
        float v = col < N ? W[(size_t)k * N + col] : 0.f; if (gk != nullptr && k < gsplit) v *= gk[k];
        scr[kk * 33 + (lane & 31)] = v; }
    LDS_WAIT(); asm volatile("" ::: "memory");
    const int c = lane & 7;
#pragma unroll
    for (int j = 0; j < 4; ++j) { const int n = (lane >> 3) + 8 * j; const LAS float* s = scr + (8 * c) * 33 + n; const int dr = dest_row<MODE>(n0 + n);
        if (n0 + n < N && dr >= 0) { v4u o; o.x = pk2(s[0 * 33], s[1 * 33]); o.y = pk2(s[2 * 33], s[3 * 33]); o.z = pk2(s[4 * 33], s[5 * 33]); o.w = pk2(s[6 * 33], s[7 * 33]);
            *(v4u*)(WT + (size_t)dr * K + k0 + 8 * c) = o; } }
    LDS_WAIT(); asm volatile("" ::: "memory");
}
__device__ __forceinline__ void p0_prologue(const Params& P, const Ctx& C) {
    LAS float* scr = (LAS float*)(C.lds + C.wave * 16384);
    constexpr int I_GU = (D / 64) * (DFF / 32), I_D = (DFF / 64) * (D / 32), I_IN = (D / 64) * ((INCOLS + 31) / 32), I_OUT = (DMIX / 64) * (D / 32);
    constexpr int PER_L = 4 * I_GU + 2 * I_D + I_IN + I_OUT;
    for (int it = C.gw; it < DEPTH * PER_L; it += C.NGW) {
        const int l = it / PER_L; int r = it % PER_L;
        if (r < I_GU) { transpose_item<1>(P.in[I_F1WG] + (size_t)l * D * DFF, D, DFF, P.in[I_F1PRE] + l * D, D, WSP(bf16, WS_WGU1) + (size_t)l * NGU * D, scr, r, C.lane); continue; } r -= I_GU;
        if (r < I_GU) { transpose_item<2>(P.in[I_F1WU] + (size_t)l * D * DFF, D, DFF, P.in[I_F1PRE] + l * D, D, WSP(bf16, WS_WGU1) + (size_t)l * NGU * D, scr, r, C.lane); continue; } r -= I_GU;
        if (r < I_GU) { transpose_item<1>(P.in[I_F2WG] + (size_t)l * D * DFF, D, DFF, P.in[I_F2PRE] + l * D, D, WSP(bf16, WS_WGU2) + (size_t)l * NGU * D, scr, r, C.lane); continue; } r -= I_GU;
        if (r < I_GU) { transpose_item<2>(P.in[I_F2WU] + (size_t)l * D * DFF, D, DFF, P.in[I_F2PRE] + l * D, D, WSP(bf16, WS_WGU2) + (size_t)l * NGU * D, scr, r, C.lane); continue; } r -= I_GU;
        if (r < I_D) { transpose_item<0>(P.in[I_F1WD] + (size_t)l * DFF * D, DFF, D, nullptr, 0, WSP(bf16, WS_WD1) + (size_t)l * D * DFF, scr, r, C.lane); continue; } r -= I_D;
        if (r < I_D) { transpose_item<0>(P.in[I_F2WD] + (size_t)l * DFF * D, DFF, D, nullptr, 0, WSP(bf16, WS_WD2) + (size_t)l * D * DFF, scr, r, C.lane); continue; } r -= I_D;
        if (r < I_IN) { transpose_item<3>(P.in[I_WIN] + (size_t)l * D * INCOLS, D, INCOLS, P.in[I_MPRE] + l * D, D, WSP(bf16, WS_WIN) + (size_t)l * NIN * D, scr, r, C.lane); continue; } r -= I_IN;
        transpose_item<0>(P.in[I_WOUT] + (size_t)l * DMIX * D, DMIX, D, P.in[I_SSDG] + l * D, D, WSP(bf16, WS_WOUT) + (size_t)l * D * DMIX, scr, r, C.lane);
    }
    for (int i = C.gw * 64 + C.lane; i < DEPTH * 16 * D; i += C.NGW * 64) { const int l = i / (16 * D), j = (i / D) % 16, k = i % D;
        WSP(float, WS_WDT)[i] = P.in[I_WIN][(size_t)l * D * INCOLS + (size_t)k * INCOLS + 2560 + j] * P.in[I_MPRE][l * D + k]; }
    for (int r = C.gw; r < MP; r += C.NGW) {
        const float* src = r < ROW_S ? P.in[I_XP] + (size_t)r * D : (r < ROW_M ? P.in[I_XS] + (size_t)(r - ROW_S) * D : (r < NROWS ? P.in[I_META] + (size_t)(r - ROW_M) * D : nullptr));
        f32x4 v[4]; float s = 0.f;
#pragma unroll
        for (int j = 0; j < 4; ++j) { v[j] = src ? ((const f32x4*)src)[C.lane + 64 * j] : (f32x4){0.f, 0.f, 0.f, 0.f}; s += (v[j].x * v[j].x + v[j].y * v[j].y) + (v[j].z * v[j].z + v[j].w * v[j].w); }
        const float rs = rsqrtf(wave_sum(s) * (1.f / D) + EPS);
#pragma unroll
        for (int j = 0; j < 4; ++j) { ((f32x4*)(WSP(float, WS_X) + (size_t)r * D))[C.lane + 64 * j] = v[j];
            v2u o; o.x = pk2(v[j].x * rs, v[j].y * rs); o.y = pk2(v[j].z * rs, v[j].w * rs); ((v2u*)(WSP(bf16, WS_XB) + (size_t)r * D))[C.lane + 64 * j] = o; }
    }
}

__device__ __forceinline__ void rn_phase(const Params& P, const Ctx& C, float cc, const float* gpost, bool do_dt, int l, bool fin) {
    LAS float* wl = (LAS float*)C.lds;
    if (do_dt) { for (int i = C.tid; i < 16 * D / 4; i += NTHR) ((LAS f32x4*)wl)[i] = ((const f32x4*)(WSP(float, WS_WDT) + (size_t)l * 16 * D))[i]; __syncthreads(); }
    for (int r = C.gw; r < NROWS; r += C.NGW) {
        f32x4 v[4]; float s = 0.f;
#pragma unroll
        for (int j = 0; j < 4; ++j) { v[j] = ((const f32x4*)(WSP(float, WS_Y) + (size_t)r * D))[C.lane + 64 * j]; s += (v[j].x * v[j].x + v[j].y * v[j].y) + (v[j].z * v[j].z + v[j].w * v[j].w); }
        const float rs = rsqrtf(wave_sum(s) * (1.f / D) + EPS) * cc; float s2 = 0.f;
#pragma unroll
        for (int j = 0; j < 4; ++j) { const f32x4 g = ((const f32x4*)gpost)[C.lane + 64 * j], x0 = ((const f32x4*)(WSP(float, WS_X) + (size_t)r * D))[C.lane + 64 * j];
            v[j] = x0 + v[j] * rs * g; s2 += (v[j].x * v[j].x + v[j].y * v[j].y) + (v[j].z * v[j].z + v[j].w * v[j].w); }
        const float rs2 = rsqrtf(wave_sum(s2) * (1.f / D) + EPS);
        if (fin) { if (r < ROW_M) {
#pragma unroll
            for (int j = 0; j < 4; ++j) ((f32x4*)(P.out + (size_t)r * D))[C.lane + 64 * j] = v[j]; } }
        else {
#pragma unroll
            for (int j = 0; j < 4; ++j) { ((f32x4*)(WSP(float, WS_X) + (size_t)r * D))[C.lane + 64 * j] = v[j];
                v2u o; o.x = pk2(v[j].x * rs2, v[j].y * rs2); o.y = pk2(v[j].z * rs2, v[j].w * rs2); ((v2u*)(WSP(bf16, WS_XB) + (size_t)r * D))[C.lane + 64 * j] = o; }
        }
        if (do_dt) { float mine = 0.f;
#pragma unroll 1
            for (int j16 = 0; j16 < 16; ++j16) { float a = 0.f;
#pragma unroll
                for (int j = 0; j < 4; ++j) { const f32x4 w = ((const LAS f32x4*)(wl + j16 * D))[C.lane + 64 * j]; a += (v[j].x * w.x + v[j].y * w.y) + (v[j].z * w.z + v[j].w * w.w); }
                a = wave_sum(a); if (C.lane == j16) mine = a; }
            if (C.lane < 16) WSP(float, WS_DT)[(size_t)r * 16 + C.lane] = softplus_f(mine * rs2 + P.in[I_DTB][l * 16 + C.lane]); }
    }
}

__device__ __forceinline__ void conv_phase(const Params& P, const Ctx& C, int l) {
    const size_t gt = (size_t)C.gw * 64 + C.lane, NT = (size_t)C.NGW * 64;
    const float* cw = P.in[I_CONVW] + (size_t)l * 4 * XBCW; const float* cb = P.in[I_CONVB] + (size_t)l * XBCW;
    for (size_t idx = gt; idx < (size_t)NROWS * (XBCW / 8); idx += NT) {
        const int r = (int)(idx / (XBCW / 8)), ch = (int)(idx % (XBCW / 8)) * 8;
        float acc[8];
        { const f32x4 b0 = *(const f32x4*)(cb + ch), b1 = *(const f32x4*)(cb + ch + 4); acc[0] = b0.x; acc[1] = b0.y; acc[2] = b0.z; acc[3] = b0.w; acc[4] = b1.x; acc[5] = b1.y; acc[6] = b1.z; acc[7] = b1.w; }
#pragma unroll
        for (int k = 0; k < 4; ++k) {
            int srow = -1; const float* fsrc = nullptr;
            if (r < ROW_S) { const int t = r & (SEQ - 1), tp = t - 3 + k; srow = tp >= 0 ? r - 3 + k : ROW_M + NMETA + tp; }
            else if (r < ROW_M) { const int q = r - ROW_S, b = q >> 2, s = q & 3, pos = s - 3 + k; if (pos >= 0) srow = ROW_S + 4 * b + pos; else fsrc = P.in[I_SSDCONV] + ((size_t)(l * NSB + b) * 3 + (3 + pos)) * XBCW + ch; }
            else { const int pos = (r - ROW_M) - 3 + k; if (pos >= 0) srow = ROW_M + pos; }
            float xv[8];
            if (srow >= 0) { const v4u w = *(const v4u*)(WSP(bf16, WS_PROJ) + (size_t)srow * NIN + PX + ch); xv[0] = bflo(w.x); xv[1] = bfhi(w.x); xv[2] = bflo(w.y); xv[3] = bfhi(w.y); xv[4] = bflo(w.z); xv[5] = bfhi(w.z); xv[6] = bflo(w.w); xv[7] = bfhi(w.w); }
            else if (fsrc) { const f32x4 a0 = *(const f32x4*)fsrc, a1 = *(const f32x4*)(fsrc + 4); xv[0] = a0.x; xv[1] = a0.y; xv[2] = a0.z; xv[3] = a0.w; xv[4] = a1.x; xv[5] = a1.y; xv[6] = a1.z; xv[7] = a1.w; }
            else {
#pragma unroll
                for (int e = 0; e < 8; ++e) xv[e] = 0.f; }
            const f32x4 w0 = *(const f32x4*)(cw + (size_t)k * XBCW + ch), w1 = *(const f32x4*)(cw + (size_t)k * XBCW + ch + 4);
            acc[0] += w0.x * xv[0]; acc[1] += w0.y * xv[1]; acc[2] += w0.z * xv[2]; acc[3] += w0.w * xv[3]; acc[4] += w1.x * xv[4]; acc[5] += w1.y * xv[5]; acc[6] += w1.z * xv[6]; acc[7] += w1.w * xv[7];
        }
        v4u o; o.x = pk2(silu_f(acc[0]), silu_f(acc[1])); o.y = pk2(silu_f(acc[2]), silu_f(acc[3])); o.z = pk2(silu_f(acc[4]), silu_f(acc[5])); o.w = pk2(silu_f(acc[6]), silu_f(acc[7]));
        *(v4u*)(WSP(bf16, WS_XBCC) + (size_t)r * XBCW + ch) = o;
    }
    for (size_t i = gt; i < (size_t)NPB * 3 * XBCW; i += NT) { const int b = (int)(i / (3 * XBCW)), j = (int)(i / XBCW) % 3, ch = (int)(i % XBCW);
        P.out[O_CONVP + (size_t)l * NPB * 3 * XBCW + i] = bf2f(WSP(bf16, WS_PROJ)[(size_t)(b * SEQ + SEQ - 3 + j) * NIN + PX + ch]); }
    for (size_t i = gt; i < (size_t)NPB * 3 * D; i += NT) { const int b = (int)(i / (3 * D)), j = (int)(i / D) % 3, ch = (int)(i % D);
        P.out[O_LCONVP + (size_t)l * NPB * 3 * D + i] = bf2f(WSP(bf16, WS_PROJ)[(size_t)(b * SEQ + SEQ - 3 + j) * NIN + PXR + ch]); }
    for (size_t i = gt; i < (size_t)NSB * 3 * XBCW; i += NT) { const int b = (int)(i / (3 * XBCW)), j = (int)(i / XBCW) % 3, ch = (int)(i % XBCW);
        P.out[O_CONVS + (size_t)l * NSB * 3 * XBCW + i] = bf2f(WSP(bf16, WS_PROJ)[(size_t)(ROW_S + 4 * b + 1 + j) * NIN + PX + ch]); }
    for (size_t i = gt; i < (size_t)NSB * 3 * D; i += NT) { const int b = (int)(i / (3 * D)), j = (int)(i / D) % 3, ch = (int)(i % D);
        P.out[O_LCONVS + (size_t)l * NSB * 3 * D + i] = bf2f(WSP(bf16, WS_PROJ)[(size_t)(ROW_S + 4 * b + 1 + j) * NIN + PXR + ch]); }
}

__device__ __forceinline__ void ssd_prompt_naive(const Params& P, const Ctx& C, int l, int b, int h) {
    const int tid = C.tid, p = tid >> 3, ng = tid & 7, g = h >> 3;
    LAS bf16* Bs = (LAS bf16*)C.lds; LAS bf16* Cs = (LAS bf16*)(C.lds + 16384); LAS bf16* Xs = (LAS bf16*)(C.lds + 32768);
    LAS float* dts = (LAS float*)(C.lds + 40960); LAS int* rws = (LAS int*)(C.lds + 41216); LAS float* yb = (LAS float*)(C.lds + 41472);
    float S[16];
#pragma unroll
    for (int i = 0; i < 16; ++i) S[i] = 0.f;
    const float a = -expf(P.in[I_ALOG][l * 16 + h]), Dh = P.in[I_SSDD][l * 16 + h];
    float* ssq = (WSP(float, WS_CTL) + CW_SSQ) + (size_t)l * MP;
    for (int c0 = 0; c0 < SEQ + NMETA; c0 += 64) {
        const int nv = (SEQ + NMETA - c0) < 64 ? (SEQ + NMETA - c0) : 64;
        { const int tl = tid >> 3, part = tid & 7;
          if (tl < nv) { const int row = prow(b, c0 + tl); const bf16* src = WSP(bf16, WS_XBCC) + (size_t)row * XBCW;
              *(LAS v4u*)(Bs + tl * 128 + part * 16) = *(const v4u*)(src + 1024 + g * 128 + part * 16); *(LAS v4u*)(Bs + tl * 128 + part * 16 + 8) = *(const v4u*)(src + 1024 + g * 128 + part * 16 + 8);
              *(LAS v4u*)(Cs + tl * 128 + part * 16) = *(const v4u*)(src + 1280 + g * 128 + part * 16); *(LAS v4u*)(Cs + tl * 128 + part * 16 + 8) = *(const v4u*)(src + 1280 + g * 128 + part * 16 + 8);
              *(LAS v4u*)(Xs + tl * 64 + part * 8) = *(const v4u*)(src + h * 64 + part * 8);
              if (part == 0) { dts[tl] = WSP(float, WS_DT)[(size_t)row * 16 + h]; rws[tl] = row; } } }
        __syncthreads();
        for (int tl = 0; tl < nv; ++tl) {
            const float dt = dts[tl], dA = __expf(dt * a), x = bf2f(Xs[tl * 64 + p]), dtx = dt * x;
            const v4u b0 = *(const LAS v4u*)(Bs + tl * 128 + ng * 16), b1 = *(const LAS v4u*)(Bs + tl * 128 + ng * 16 + 8), c0v = *(const LAS v4u*)(Cs + tl * 128 + ng * 16), c1v = *(const LAS v4u*)(Cs + tl * 128 + ng * 16 + 8);
            float acc = 0.f;
#pragma unroll
            for (int w = 0; w < 4; ++w) { const unsigned bw = b0[w], cwd = c0v[w];
                S[2 * w] = dA * S[2 * w] + dtx * bflo(bw); acc += S[2 * w] * bflo(cwd); S[2 * w + 1] = dA * S[2 * w + 1] + dtx * bfhi(bw); acc += S[2 * w + 1] * bfhi(cwd); }
#pragma unroll
            for (int w = 0; w < 4; ++w) { const unsigned bw = b1[w], cwd = c1v[w];
                S[8 + 2 * w] = dA * S[8 + 2 * w] + dtx * bflo(bw); acc += S[8 + 2 * w] * bflo(cwd); S[8 + 2 * w + 1] = dA * S[8 + 2 * w + 1] + dtx * bfhi(bw); acc += S[8 + 2 * w + 1] * bfhi(cwd); }
            acc += __shfl_xor(acc, 1); acc += __shfl_xor(acc, 2); acc += __shfl_xor(acc, 4);
            if (ng == 0) yb[tl * 64 + p] = acc + Dh * x;
        }
        __syncthreads();
        { const int tl = tid >> 3, pp = (tid & 7) * 8; float sq = 0.f; int row = 0;
          const bool act = tl < nv && (b == 0 || c0 + tl >= NMETA);
          if (act) { row = rws[tl]; const v4u z = *(const v4u*)(WSP(bf16, WS_PROJ) + (size_t)row * NIN + PZ + h * 64 + pp); float y[8];
              y[0] = yb[tl * 64 + pp + 0] * silu_f(bflo(z.x)); y[1] = yb[tl * 64 + pp + 1] * silu_f(bfhi(z.x)); y[2] = yb[tl * 64 + pp + 2] * silu_f(bflo(z.y)); y[3] = yb[tl * 64 + pp + 3] * silu_f(bfhi(z.y));
              y[4] = yb[tl * 64 + pp + 4] * silu_f(bflo(z.z)); y[5] = yb[tl * 64 + pp + 5] * silu_f(bfhi(z.z)); y[6] = yb[tl * 64 + pp + 6] * silu_f(bflo(z.w)); y[7] = yb[tl * 64 + pp + 7] * silu_f(bfhi(z.w));
#pragma unroll
              for (int e = 0; e < 8; ++e) sq += y[e] * y[e];
              v4u o; o.x = pk2(y[0], y[1]); o.y = pk2(y[2], y[3]); o.z = pk2(y[4], y[5]); o.w = pk2(y[6], y[7]);
              *(v4u*)(WSP(bf16, WS_YMIX) + (size_t)row * DMIX + h * 64 + pp) = o; }
          sq += __shfl_xor(sq, 1); sq += __shfl_xor(sq, 2); sq += __shfl_xor(sq, 4);
          if (act && (tid & 7) == 0) atomicAdd(ssq + row, sq); }
        __syncthreads();
    }
    float* o = P.out + O_SSDP + (((size_t)(l * NPB + b) * 16 + h) * 64 + p) * 128 + ng * 16;
#pragma unroll
    for (int i = 0; i < 4; ++i) ((f32x4*)o)[i] = (f32x4){S[4 * i], S[4 * i + 1], S[4 * i + 2], S[4 * i + 3]};
}

__device__ __forceinline__ void ssd_sample_item(const Params& P, const Ctx& C, int l, int b, int h) {
    const int t2 = C.tid & 255, p = t2 >> 2, nq = t2 & 3, g = h >> 3;
    const float a = -expf(P.in[I_ALOG][l * 16 + h]), Dh = P.in[I_SSDD][l * 16 + h];
    const size_t soff = (((size_t)(l * NSB + b) * 16 + h) * 64 + p) * 128 + nq * 32;
    const float* sp = P.in[I_SSD] + soff;
    f32x4 S[8];
#pragma unroll
    for (int i = 0; i < 8; ++i) S[i] = ((const f32x4*)sp)[i];
    float* ssq = (WSP(float, WS_CTL) + CW_SSQ) + (size_t)l * MP;
#pragma unroll 1
    for (int s = 0; s < 4; ++s) {
        const int row = ROW_S + 4 * b + s; const bf16* src = WSP(bf16, WS_XBCC) + (size_t)row * XBCW;
        const float dt = WSP(float, WS_DT)[(size_t)row * 16 + h], dA = __expf(dt * a), x = bf2f(src[h * 64 + p]), dtx = dt * x;
        float acc = 0.f;
#pragma unroll
        for (int i = 0; i < 4; ++i) { const v4u bw = *(const v4u*)(src + 1024 + g * 128 + nq * 32 + 8 * i), cwv = *(const v4u*)(src + 1280 + g * 128 + nq * 32 + 8 * i);
            f32x4 s0 = S[2 * i], s1 = S[2 * i + 1];
            s0.x = dA * s0.x + dtx * bflo(bw.x); acc += s0.x * bflo(cwv.x); s0.y = dA * s0.y + dtx * bfhi(bw.x); acc += s0.y * bfhi(cwv.x);
            s0.z = dA * s0.z + dtx * bflo(bw.y); acc += s0.z * bflo(cwv.y); s0.w = dA * s0.w + dtx * bfhi(bw.y); acc += s0.w * bfhi(cwv.y);
            s1.x = dA * s1.x + dtx * bflo(bw.z); acc += s1.x * bflo(cwv.z); s1.y = dA * s1.y + dtx * bfhi(bw.z); acc += s1.y * bfhi(cwv.z);
            s1.z = dA * s1.z + dtx * bflo(bw.w); acc += s1.z * bflo(cwv.w); s1.w = dA * s1.w + dtx * bfhi(bw.w); acc += s1.w * bfhi(cwv.w);
            S[2 * i] = s0; S[2 * i + 1] = s1; }
        acc += __shfl_xor(acc, 1); acc += __shfl_xor(acc, 2);
        const float z = bf2f(WSP(bf16, WS_PROJ)[(size_t)row * NIN + PZ + h * 64 + p]);
        const float y = (acc + Dh * x) * silu_f(z);
        float sq = (nq == 0) ? y * y : 0.f;
        if (nq == 0) WSP(bf16, WS_YMIX)[(size_t)row * DMIX + h * 64 + p] = (bf16)f2bf(y);
        sq = wave_sum(sq);
        if (C.lane == 0) atomicAdd(ssq + row, sq);
    }
    float* o = P.out + O_SSDS + soff;
#pragma unroll
    for (int i = 0; i < 8; ++i) ((f32x4*)o)[i] = S[i];
}

template <bool SAMPLE> __device__ __forceinline__ void lru_item(const Params& P, const Ctx& C, int l, int sq, int k) {
    const int tid = C.tid, c = tid & 63, w = tid >> 6, ch = k * 64 + c;
    LAS float* XC = (LAS float*)C.lds; LAS float* AV = (LAS float*)(C.lds + 32768); LAS float* BV = (LAS float*)(C.lds + 65536);
    LAS float* SA = (LAS float*)(C.lds + 98304); LAS float* SB = (LAS float*)(C.lds + 98304 + 2048);
    const float* pa = P.in[I_LWA] + ((size_t)(l * 16 + k) * 64) * 64 + c; const float* px = P.in[I_LWX] + ((size_t)(l * 16 + k) * 64) * 64 + c;
    const float ba = P.in[I_LBA][l * D + ch], bx = P.in[I_LBX][l * D + ch], spl = softplus_f(-P.in[I_LLAM][l * D + ch]), cb = P.in[I_LCONVB][l * D + ch];
    float cwk[4];
#pragma unroll
    for (int kk = 0; kk < 4; ++kk) cwk[kk] = P.in[I_LCONVW][(size_t)(l * 4 + kk) * D + ch];
    const bf16* proj = WSP(bf16, WS_PROJ); bf16* ymix = WSP(bf16, WS_YMIX);
    float carry = 0.f;
    const int nch = SAMPLE ? 1 : 17;
#pragma unroll 1
    for (int ci = 0; ci < nch; ++ci) {
#pragma unroll 2
        for (int j = 0; j < 16; ++j) { const int t = 16 * w + j; float acc = cb;
            if (SAMPLE) { const int row = ROW_S + 128 * sq + t, bb = 32 * sq + (t >> 2), s = t & 3;
#pragma unroll
                for (int kk = 0; kk < 4; ++kk) { const int pos = s - 3 + kk;
                    const float v = pos >= 0 ? bf2f(proj[(size_t)(row - s + pos) * NIN + PXR + ch]) : P.in[I_LRUCONV][((size_t)(l * NSB + bb) * 3 + (3 + pos)) * D + ch];
                    acc += cwk[kk] * v; } }
            else { const int tt = ci == 0 ? t : NMETA + 128 * (ci - 1) + t; const bool valid = ci > 0 || t < NMETA;
#pragma unroll
                for (int kk = 0; kk < 4; ++kk) { const int tp = tt - 3 + kk;
                    const float v = (valid && tp >= 0) ? bf2f(proj[(size_t)prow(sq, tp) * NIN + PXR + ch]) : 0.f;
                    acc += cwk[kk] * v; } }
            XC[t * 64 + c] = acc; }
        __syncthreads();
        float Ap = 1.f, hl = 0.f;
        { float wv[64]; const float* pa2 = pa; const float* px2 = px; asm volatile("" : "+v"(pa2), "+v"(px2));
#pragma unroll
          for (int i = 0; i < 64; ++i) wv[i] = pa2[i * 64];
#pragma unroll 2
          for (int j = 0; j < 16; ++j) { const int t = 16 * w + j; float rp = ba;
#pragma unroll
              for (int i = 0; i < 64; i += 4) { const f32x4 xv = *(const LAS f32x4*)(XC + t * 64 + i); rp += (xv.x * wv[i] + xv.y * wv[i + 1]) + (xv.z * wv[i + 2] + xv.w * wv[i + 3]); }
              AV[t * 64 + c] = -8.0f * sigmoid_f(rp) * spl; }
          asm volatile("" ::: "memory");
#pragma unroll
          for (int i = 0; i < 64; ++i) wv[i] = px2[i * 64];
#pragma unroll 2
          for (int j = 0; j < 16; ++j) { const int t = 16 * w + j; float ip = bx;
#pragma unroll
              for (int i = 0; i < 64; i += 4) { const f32x4 xv = *(const LAS f32x4*)(XC + t * 64 + i); ip += (xv.x * wv[i] + xv.y * wv[i + 1]) + (xv.z * wv[i + 2] + xv.w * wv[i + 3]); }
              const float la = AV[t * 64 + c]; float a = __expf(la); float bt = sqrtf(-expm1f(2.0f * la)) * sigmoid_f(ip) * XC[t * 64 + c];
              if (SAMPLE) { const int bb = 32 * sq + (t >> 2); if ((t & 3) == 0) { bt += a * P.in[I_LRU][(size_t)(l * NSB + bb) * D + ch]; a = 0.f; } }
              else { if (ci == 0 && t >= NMETA) { a = 1.f; bt = 0.f; } }
              AV[t * 64 + c] = a; BV[t * 64 + c] = bt; hl = a * hl + bt; Ap *= a; } }
        SA[w * 64 + c] = Ap; SB[w * 64 + c] = hl;
        __syncthreads();
        float hin = carry, tot = carry;
#pragma unroll
        for (int w2 = 0; w2 < 8; ++w2) { const float A2 = SA[w2 * 64 + c], B2 = SB[w2 * 64 + c]; tot = A2 * tot + B2; if (w2 < w) hin = A2 * hin + B2; }
        float hc = hin;
#pragma unroll 2
        for (int j = 0; j < 16; ++j) { const int t = 16 * w + j; hc = AV[t * 64 + c] * hc + BV[t * 64 + c];
            int row; bool wr_;
            if (SAMPLE) { row = ROW_S + 128 * sq + t; wr_ = true; if ((t & 3) == 3) P.out[O_LRUS + (size_t)(l * NSB + 32 * sq + (t >> 2)) * D + ch] = hc; }
            else { const int tt = ci == 0 ? t : NMETA + 128 * (ci - 1) + t; row = prow(sq, tt); wr_ = ci > 0 || (t < NMETA && sq == 0); }
            if (wr_) { const float gt = bf2f(proj[(size_t)row * NIN + PGATE + ch]); ymix[(size_t)row * DMIX + D + ch] = (bf16)f2bf(hc * gelu_tanh_f(gt)); } }
        carry = tot;
        __syncthreads();
    }
    if (!SAMPLE && w == 0) P.out[O_LRUP + (size_t)(l * NPB + sq) * D + ch] = carry;
}

__device__ __forceinline__ void mixer_phase(const Params& P, const Ctx& C, int l) {
    const int bx = blockIdx.x;
    if (bx < 128) ssd_prompt_naive(P, C, l, bx >> 4, bx & 15);
    else if (bx < 256) lru_item<false>(P, C, l, (bx - 128) >> 4, (bx - 128) & 15);
    if (bx >= 128 && bx < 256) { const int vb = bx - 128;
        if (vb < 64) lru_item<true>(P, C, l, vb >> 4, vb & 15);
        for (int it = vb; it < NSB * 16 / 2; it += 128) { const int id = it * 2 + (C.tid >> 8); ssd_sample_item(P, C, l, id >> 4, id & 15); }
    }
}

__device__ __forceinline__ void ynorm_phase(const Params& P, const Ctx& C, int l) {
    const float* ssq = (WSP(float, WS_CTL) + CW_SSQ) + (size_t)l * MP;
    for (int r = C.gw; r < NROWS; r += C.NGW) {
        const float rs = rsqrtf(ssq[r] * (1.f / D) + EPS);
        v4u* p = (v4u*)(WSP(bf16, WS_YMIX) + (size_t)r * DMIX) + 2 * C.lane;
#pragma unroll
        for (int i = 0; i < 2; ++i) { v4u w = p[i];
            w.x = pk2(bflo(w.x) * rs, bfhi(w.x) * rs); w.y = pk2(bflo(w.y) * rs, bfhi(w.y) * rs); w.z = pk2(bflo(w.z) * rs, bfhi(w.z) * rs); w.w = pk2(bflo(w.w) * rs, bfhi(w.w) * rs);
            p[i] = w; }
    }
}

constexpr int NPHASE = 1 + 12 * DEPTH;
__global__ void __launch_bounds__(NTHR, 2) hymba_fwd(Params P) {
    extern __shared__ __attribute__((aligned(16))) unsigned char lds_raw[];
    Ctx C;
    C.lds = (LAS unsigned char*)lds_raw;
    C.tid = threadIdx.x; C.lane = C.tid & 63; C.wave = __builtin_amdgcn_readfirstlane(C.tid >> 6);
    C.G = gridDim.x; C.gw = blockIdx.x * NWAVES + C.wave; C.NGW = C.G * NWAVES;
    unsigned char* ws = P.ws;
    volatile LAS unsigned* MISC = (volatile LAS unsigned*)(C.lds + MISC_OFF);
    for (int u = C.tid; u < (LDS_BYTES - RING_BYTES) / 4; u += NTHR) ((LAS unsigned*)(C.lds + RING_BYTES))[u] = 0u;
    __syncthreads();
#if MEGA
    XcdBarrier bar = xcd_barrier_post((unsigned*)(ws + WS_CTL) + CW_BAR, MISC + 8);
#endif
    const int lo = P.ph_lo, hi = P.ph_hi;
#define IN(k) (lo <= (k) && (k) < hi)
#if MEGA
#define SEAM(k) do { if (IN(k) && IN((k) + 1)) xcd_barrier(bar); } while (0)
#else
#define SEAM(k) do { } while (0)
#endif
#define GEMM_PHASE(Aop, Btop, Nn, Kk, kind, perm, outp, ldo) do { pg8::Gemm g{Aop, Btop, MP, Nn, Kk}; pg8::StaticOrder S; S.init(MP, Nn, C.G, (int)blockIdx.x); \
        pg8::EpiAny E{kind, perm, outp, ldo}; pg8::gemm_phase<pg8::EpiAny, pg8::StaticOrder, true, true>(C.lds, g, S, E); } while (0)
    if (IN(0)) p0_prologue(P, C);
#if MEGA
    if (IN(0) && IN(1)) { VM_WAIT(); __syncthreads(); cg::this_grid().sync(); }
#endif
#define LAYER(l) do { constexpr int b0 = 1 + 12 * (l); \
    if (IN(b0 + 0)) GEMM_PHASE(WSP(bf16, WS_XB), WSP(bf16, WS_WGU1) + (size_t)(l) * NGU * D, NGU, D, 2, false, WSP(bf16, WS_H), DFF); SEAM(b0 + 0); \
    if (IN(b0 + 1)) GEMM_PHASE(WSP(bf16, WS_H), WSP(bf16, WS_WD1) + (size_t)(l) * D * DFF, D, DFF, 0, false, WSP(float, WS_Y), D); SEAM(b0 + 1); \
    if (IN(b0 + 2)) rn_phase(P, C, 0.5f, P.in[I_F1POST] + (l) * D, true, (l), false); SEAM(b0 + 2); \
    if (IN(b0 + 3)) GEMM_PHASE(WSP(bf16, WS_XB), WSP(bf16, WS_WIN) + (size_t)(l) * NIN * D, NIN, D, 1, true, WSP(bf16, WS_PROJ), NIN); SEAM(b0 + 3); \
    if (IN(b0 + 4)) conv_phase(P, C, (l)); SEAM(b0 + 4); \
    if (IN(b0 + 5)) mixer_phase(P, C, (l)); SEAM(b0 + 5); \
    if (IN(b0 + 6)) ynorm_phase(P, C, (l)); SEAM(b0 + 6); \
    if (IN(b0 + 7)) GEMM_PHASE(WSP(bf16, WS_YMIX), WSP(bf16, WS_WOUT) + (size_t)(l) * D * DMIX, D, DMIX, 0, false, WSP(float, WS_Y), D); SEAM(b0 + 7); \
    if (IN(b0 + 8)) rn_phase(P, C, 1.0f, P.in[I_MPOST] + (l) * D, false, (l), false); SEAM(b0 + 8); \
    if (IN(b0 + 9)) GEMM_PHASE(WSP(bf16, WS_XB), WSP(bf16, WS_WGU2) + (size_t)(l) * NGU * D, NGU, D, 2, false, WSP(bf16, WS_H), DFF); SEAM(b0 + 9); \
    if (IN(b0 + 10)) GEMM_PHASE(WSP(bf16, WS_H), WSP(bf16, WS_WD2) + (size_t)(l) * D * DFF, D, DFF, 0, false, WSP(float, WS_Y), D); SEAM(b0 + 10); \
    if (IN(b0 + 11)) rn_phase(P, C, 0.5f, P.in[I_F2POST] + (l) * D, false, (l), (l) == DEPTH - 1); SEAM(b0 + 11); } while (0)
    LAYER(0);
    LAYER(1);
}

extern "C" void kernel_launch(void* const* d_in, const int* in_sizes, int n_in, void* d_out, int out_size, void* d_ws, size_t ws_size, hipStream_t stream) {
    static int grid = 0;
    if (grid == 0) {
        if (n_in != N_IN || out_size != (int)O_END || ws_size < WS_END) { fprintf(stderr, "kernel_launch: built for %d inputs, %zu outputs, >= %zu bytes of workspace; got n_in %d, out %d, ws %zu; nothing launched\n", (int)N_IN, (size_t)O_END, (size_t)WS_END, n_in, out_size, ws_size); grid = -1; return; }
        int dev = 0, cus = 0, per_cu = 0;
        if (hipGetDevice(&dev) != hipSuccess || hipDeviceGetAttribute(&cus, hipDeviceAttributeMultiprocessorCount, dev) != hipSuccess) { fprintf(stderr, "kernel_launch: device query failed\n"); grid = -1; return; }
        if (hipFuncSetAttribute((const void*)hymba_fwd, hipFuncAttributeMaxDynamicSharedMemorySize, LDS_BYTES) != hipSuccess) { fprintf(stderr, "kernel_launch: hipFuncSetAttribute failed\n"); grid = -1; return; }
        if (hipOccupancyMaxActiveBlocksPerMultiprocessor(&per_cu, (const void*)hymba_fwd, NTHR, LDS_BYTES) != hipSuccess || per_cu < 1) { fprintf(stderr, "kernel_launch: occupancy query says %d blocks per CU\n", per_cu); grid = -1; return; }
        (void)hipGetLastError();
        grid = cus * per_cu; if (grid > 256) grid = 256;
        if (grid != 256) { fprintf(stderr, "kernel_launch: this kernel needs a 256-workgroup resident grid (got %d CUs x %d)\n", cus, per_cu); grid = -1; return; }
    }
    if (grid < 0) return;
    if (hipMemsetAsync((char*)d_ws + WS_CTL, 0, CTL_ZERO_BYTES, stream) != hipSuccess) { fprintf(stderr, "kernel_launch: hipMemsetAsync failed\n"); return; }
    Params a{};
    for (int i = 0; i < N_IN; ++i) a.in[i] = (const float*)d_in[i];
    a.out = (float*)d_out; a.ws = (unsigned char*)d_ws;
#if MEGA
    a.ph_lo = 0; a.ph_hi = NPHASE;
    void* args[] = {&a};
    hipError_t e = hipLaunchCooperativeKernel((const void*)hymba_fwd, dim3(grid), dim3(NTHR), args, LDS_BYTES, stream);
    if (e != hipSuccess) fprintf(stderr, "kernel_launch: cooperative launch failed: %s (grid %d)\n", hipGetErrorString(e), grid);
#else
    for (int ph = 0; ph < NPHASE; ++ph) { a.ph_lo = ph; a.ph_hi = ph + 1; hipLaunchKernelGGL(hymba_fwd, dim3(grid), dim3(NTHR), LDS_BYTES, stream, a); }
#endif
}
```

```cpp
#include <hip/hip_runtime.h>
#include <hip/hip_cooperative_groups.h>
#include <cstdio>
#include <cstdint>
namespace cg = cooperative_groups;

#ifndef SSD_NAIVE
#define SSD_NAIVE 0
#endif
#ifndef MEGA
#define MEGA 1
#endif

constexpr int D = 1024, DFF = 2816, NGU = 2 * DFF, NIN = 4608, DMIX = 2048, XBCW = 1536, INCOLS = 4624, DEPTH = 2;
constexpr int NPB = 8, SEQ = 2048, NSB = 128, NMETA = 16;
constexpr int ROW_S = 16384, ROW_M = 16896, NROWS = 16912, MP = 17152;
constexpr int PZ = 0, PX = 1024, PB = 2048, PC = 2304, PGATE = 2560, PXR = 3584;
constexpr float EPS = 1e-6f;
constexpr size_t O_YP = 0, O_YS = 16777216, O_SSDP = 17301504, O_CONVP = 19398656, O_LRUP = 19472384, O_LCONVP = 19488768, O_SSDS = 19537920, O_CONVS = 53092352, O_LRUS = 54272000, O_LCONVS = 54534144, O_END = 55320576;
enum { I_XP = 0, I_XS, I_SSD, I_SSDCONV, I_LRU, I_LRUCONV, I_META, I_F1PRE, I_F1POST, I_F1WG, I_F1WU, I_F1WD, I_MPRE, I_MPOST, I_WIN, I_CONVW, I_CONVB, I_DTB, I_ALOG, I_SSDD, I_SSDG,
       I_LCONVW, I_LCONVB, I_LWA, I_LBA, I_LWX, I_LBX, I_LLAM, I_WOUT, I_F2PRE, I_F2POST, I_F2WG, I_F2WU, I_F2WD, N_IN };
constexpr size_t MiB = 1u << 20;
constexpr size_t WS_CTL = 0, CTL_ZERO_BYTES = 1 * MiB;
constexpr size_t WS_WGU1 = 2 * MiB, WS_WD1 = 24 * MiB, WS_WIN = 35 * MiB, WS_WOUT = 53 * MiB, WS_WGU2 = 61 * MiB, WS_WD2 = 83 * MiB, WS_WDT = 94 * MiB;
constexpr size_t SZ_WGU = (size_t)NGU * D * 2, SZ_WD = (size_t)D * DFF * 2, SZ_WIN = (size_t)NIN * D * 2, SZ_WOUT = (size_t)D * DMIX * 2, SZ_WDT = 16 * D * 4;
constexpr size_t WS_XB = 95 * MiB, WS_X = 129 * MiB, WS_Y = 196 * MiB, WS_H = 263 * MiB, WS_PROJ = 356 * MiB, WS_XBCC = 507 * MiB, WS_DT = 558 * MiB, WS_YMIX = 560 * MiB, WS_END = 627 * MiB;
static_assert(WS_WGU1 + 2 * SZ_WGU <= WS_WD1 && WS_WD1 + 2 * SZ_WD <= WS_WIN && WS_WIN + 2 * SZ_WIN <= WS_WOUT && WS_WOUT + 2 * SZ_WOUT <= WS_WGU2 && WS_WGU2 + 2 * SZ_WGU <= WS_WD2 && WS_WD2 + 2 * SZ_WD <= WS_WDT && WS_WDT + 2 * SZ_WDT <= WS_XB, "weights map");
static_assert(WS_XB + (size_t)MP * D * 2 <= WS_X && WS_X + (size_t)MP * D * 4 <= WS_Y && WS_Y + (size_t)MP * D * 4 <= WS_H && WS_H + (size_t)MP * DFF * 2 <= WS_PROJ && WS_PROJ + (size_t)MP * NIN * 2 <= WS_XBCC &&
              WS_XBCC + (size_t)MP * XBCW * 2 <= WS_DT && WS_DT + (size_t)MP * 16 * 4 <= WS_YMIX && WS_YMIX + (size_t)MP * DMIX * 2 <= WS_END, "activation map");
constexpr int CW_BAR = 4096, CW_SSQ = 65536;
static_assert((size_t)(CW_SSQ + 2 * MP) * 4 <= CTL_ZERO_BYTES, "ctl map");
constexpr int RING_BYTES = 131072, LDS_BYTES = 163840, MISC_OFF = LDS_BYTES - 128;
constexpr int NWAVES = 8, NTHR = 512;
namespace pg8 {
#define PG8_LAS __attribute__((address_space(3)))
typedef unsigned short bf16_t;
typedef short bf16x8 __attribute__((ext_vector_type(8)));
typedef float f32x4 __attribute__((ext_vector_type(4)));
typedef unsigned u32x4 __attribute__((ext_vector_type(4)));
constexpr int BM = 256, BK = 64, HALF = 128, HTB = HALF * BK * 2  , STAGE_BYTES = 8 * HTB, NXCD = 8, WGM = 8;

__host__ __device__ __forceinline__ int lds_byte(int r, int c) { const int st = (r >> 4) * 2 + (c >> 5), rr = r & 15, cc = c & 31, ob = rr * 64 + cc * 2; return st * 1024 + (ob ^ (((ob >> 9) & 1) << 5)); }
__host__ __device__ __forceinline__ void stage_rc(int b, int& R, int& C) { const int st = b / 1024, sb = b % 1024, swz = sb ^ (((sb >> 9) & 1) << 5); R = (st >> 1) * 16 + swz / 64; C = (st & 1) * 32 + (swz % 64) / 2; }
__host__ __device__ __forceinline__ int perm32(int rho) { const int n = rho >> 4, i = rho & 15; return 8 * (i >> 2) + 4 * n + (i & 3); }

struct Unit { int pm, pn; };
struct Gemm { const bf16_t* A; const bf16_t* Bt; int M, N, K; };

struct StaticOrder {
    int nM, nN, nwg, G, c;
    __host__ __device__ void init(int M, int N, int G_, int c_) { nM = M / BM; nN = N / BM; nwg = nM * nN; G = G_; c = c_; }
    __host__ __device__ bool next(int i, Unit& u) const {
        const long L = (long)i * G + c; if (L >= nwg) return false;
        int wgid = (int)L; { const int q = nwg / NXCD, r = nwg % NXCD, xcd = wgid % NXCD, off = wgid / NXCD; wgid = (xcd < r ? xcd * (q + 1) : r * (q + 1) + (xcd - r) * q) + off; }
        const int nig = WGM * nN, gid = wgid / nig, fm = gid * WGM, gsz = (nM - fm) < WGM ? (nM - fm) : WGM;
        u.pm = fm + ((wgid % nig) % gsz); u.pn = (wgid % nig) / gsz; return true;
    }
    __device__ __forceinline__ void a_ready(const Unit&) const {}
    __device__ __forceinline__ void done(const Unit&) const {}
};
__device__ __forceinline__ unsigned cvt_pk_bf16(float lo, float hi) { unsigned r; asm volatile("v_cvt_pk_bf16_f32 %0, %1, %2" : "=v"(r) : "v"(lo), "v"(hi)); return r; }
typedef unsigned u32x2 __attribute__((ext_vector_type(2)));
struct EpiF32 {
    static constexpr bool PERM = false, AFTER_DRAIN = false;
    float* C; int ldc;
    __device__ __forceinline__ void operator()(const f32x4 (&acc)[2][2][4][2], const Unit& u, int wr, int wc, int fr, int fq) const {
        const int row0 = u.pm * BM + wr * 64 + fr, col0 = u.pn * BM + wc * 32 + 4 * fq;
#pragma unroll
        for (int ai = 0; ai < 2; ++ai)
#pragma unroll
            for (int m = 0; m < 4; ++m) { float* rowp = C + (size_t)(row0 + ai * HALF + m * 16) * ldc + col0;
#pragma unroll
                for (int bj = 0; bj < 2; ++bj)
#pragma unroll
                    for (int n = 0; n < 2; ++n) *(f32x4*)(rowp + bj * HALF + n * 16) = acc[ai][bj][m][n]; }
    }
};
struct EpiBf16P {
    static constexpr bool PERM = true, AFTER_DRAIN = false;
    bf16_t* O; int ldc;
    __device__ __forceinline__ void operator()(const f32x4 (&acc)[2][2][4][2], const Unit& u, int wr, int wc, int fr, int fq) const {
        const int row0 = u.pm * BM + wr * 64 + fr, col0 = u.pn * BM + wc * 32 + 8 * fq;
#pragma unroll
        for (int ai = 0; ai < 2; ++ai)
#pragma unroll
            for (int m = 0; m < 4; ++m) { bf16_t* rowp = O + (size_t)(row0 + ai * HALF + m * 16) * ldc + col0;
#pragma unroll
                for (int bj = 0; bj < 2; ++bj) { const f32x4 v0 = acc[ai][bj][m][0], v1 = acc[ai][bj][m][1];
                    u32x4 w; w.x = cvt_pk_bf16(v0[0], v0[1]); w.y = cvt_pk_bf16(v0[2], v0[3]); w.z = cvt_pk_bf16(v1[0], v1[1]); w.w = cvt_pk_bf16(v1[2], v1[3]);
                    *(u32x4*)(rowp + bj * HALF) = w; } }
    }
};
struct EpiSwiGLU {
    static constexpr bool PERM = false, AFTER_DRAIN = false;
    bf16_t* Hb; int ldh;
    __device__ __forceinline__ void operator()(const f32x4 (&acc)[2][2][4][2], const Unit& u, int wr, int wc, int fr, int fq) const {
        const int row0 = u.pm * BM + wr * 64 + fr;
#pragma unroll
        for (int ai = 0; ai < 2; ++ai)
#pragma unroll
            for (int m = 0; m < 4; ++m) { bf16_t* rowp = Hb + (size_t)(row0 + ai * HALF + m * 16) * ldh;
#pragma unroll
                for (int bj = 0; bj < 2; ++bj) { const int grp = u.pn * 8 + bj * 4 + wc; const f32x4 g = acc[ai][bj][m][0], up = acc[ai][bj][m][1]; float h[4];
#pragma unroll
                    for (int j = 0; j < 4; ++j) h[j] = g[j] * __builtin_amdgcn_rcpf(1.0f + __expf(-g[j])) * up[j];
                    u32x2 w; w.x = cvt_pk_bf16(h[0], h[1]); w.y = cvt_pk_bf16(h[2], h[3]);
                    *(u32x2*)(rowp + grp * 16 + 4 * fq) = w; } }
    }
};

struct EpiAny {
    static constexpr bool AFTER_DRAIN = false;
    int kind; bool perm; void* out; int ld;
    __device__ __forceinline__ void operator()(const f32x4 (&acc)[2][2][4][2], const Unit& u, int wr, int wc, int fr, int fq) const {
        if (kind == 0) { EpiF32 e{(float*)out, ld}; e(acc, u, wr, wc, fr, fq); }
        else if (kind == 1) { EpiBf16P e{(bf16_t*)out, ld}; e(acc, u, wr, wc, fr, fq); }
        else { EpiSwiGLU e{(bf16_t*)out, ld}; e(acc, u, wr, wc, fr, fq); }
    }
};
template <class Epi, class Sched, bool ALIGN_EPI = false, bool SP2 = false>
__device__ __forceinline__ void gemm_phase(PG8_LAS unsigned char* lds, const Gemm g, const Sched& S, const Epi& E) {
    const int tid = threadIdx.x, wid = __builtin_amdgcn_readfirstlane(tid >> 6), lane = tid & 63, wr = wid >> 2, wc = wid & 3, fr = lane & 15, fq = lane >> 4;
    const int K = g.K, nt = K / BK;
    unsigned voffA[2], voffB[2];
#pragma unroll
    for (int i = 0; i < 2; ++i) { int R, C; stage_rc(tid * 16 + i * 8192, R, C); const int Rb = E.perm ? ((R & ~31) + perm32(R & 31)) : R;
        voffA[i] = (unsigned)(R * K + C) * 2u; voffB[i] = (unsigned)(Rb * K + C) * 2u; }
    const size_t kstep = (size_t)(BK * 2);
    const size_t hstep = (size_t)HALF * K * 2;
    const size_t tstep = 2 * hstep;
    const unsigned ldsw = (unsigned)wid * 1024u;
    const int aoff = lds_byte(wr * 64 + fr, fq * 8), boff = lds_byte(wc * 32 + fr, fq * 8);
#define PG8_SA(b, h) (((b) * 2 + (h)) * HTB)
#define PG8_SB(b, h) ((4 + (b) * 2 + (h)) * HTB)
#define PG8_STAGE(bufoff, gbase, voff) do { _Pragma("unroll") for (int _i = 0; _i < 2; ++_i) \
        __builtin_amdgcn_global_load_lds((const unsigned*)((const char*)(gbase) + (voff)[_i]), (PG8_LAS unsigned*)(lds + (bufoff) + ldsw + _i * 8192), 16, 0, 0); } while (0)
#define PG8_LDA(dst, b, h) do { _Pragma("unroll") for (int m = 0; m < 4; ++m) _Pragma("unroll") for (int k = 0; k < 2; ++k) dst[m][k] = *(const PG8_LAS bf16x8*)(lds + PG8_SA(b, h) + aoff + m * 2048 + k * 1024); } while (0)
#define PG8_LDB(dst, b, h) do { _Pragma("unroll") for (int n = 0; n < 2; ++n) _Pragma("unroll") for (int k = 0; k < 2; ++k) dst[n][k] = *(const PG8_LAS bf16x8*)(lds + PG8_SB(b, h) + boff + n * 2048 + k * 1024); } while (0)
#define PG8_MMA(ai, bj, At, Bt) do { __builtin_amdgcn_s_setprio(1); _Pragma("unroll") for (int m = 0; m < 4; ++m) _Pragma("unroll") for (int n = 0; n < 2; ++n) _Pragma("unroll") for (int k = 0; k < 2; ++k) \
        acc[ai][bj][m][n] = __builtin_amdgcn_mfma_f32_16x16x32_bf16(Bt[n][k], At[m][k], acc[ai][bj][m][n], 0, 0, 0); __builtin_amdgcn_s_setprio(0); } while (0)
#define PG8_WAIT_V(n) asm volatile("s_waitcnt vmcnt(" #n ")" ::: "memory")
#define PG8_WAIT_L(n) asm volatile("s_waitcnt lgkmcnt(" #n ")" ::: "memory")
#define PG8_BAR __builtin_amdgcn_s_barrier()
#define PG8_SCHED __builtin_amdgcn_sched_barrier(0)
    Unit cur, nxt; int ui = 0;
    if (!S.next(0, cur)) return;
    f32x4 acc[2][2][4][2];
#pragma unroll
    for (int a = 0; a < 2; ++a)
#pragma unroll
        for (int b = 0; b < 2; ++b)
#pragma unroll
            for (int m = 0; m < 4; ++m)
#pragma unroll
                for (int n = 0; n < 2; ++n) acc[a][b][m][n] = (f32x4){0.f, 0.f, 0.f, 0.f};
    bf16x8 At[4][2], B0[2][2], B1[2][2];
    const char* cA = (const char*)g.A + (size_t)cur.pm * tstep; const char* cB = (const char*)g.Bt + (size_t)cur.pn * tstep;
    S.a_ready(cur);
    if constexpr (SP2) {
        PG8_STAGE(PG8_SB(0, 0), cB, voffB); PG8_STAGE(PG8_SB(0, 1), cB + hstep, voffB); PG8_STAGE(PG8_SA(0, 0), cA, voffA); PG8_STAGE(PG8_SA(0, 1), cA + hstep, voffA);
        if (wr == 1) PG8_BAR;
        PG8_WAIT_V(2); PG8_BAR;
        PG8_STAGE(PG8_SB(1, 0), cB + kstep, voffB); PG8_STAGE(PG8_SA(1, 0), cA + kstep, voffA); PG8_STAGE(PG8_SB(1, 1), cB + hstep + kstep, voffB);
        PG8_WAIT_V(6); PG8_BAR;
    } else {
        PG8_STAGE(PG8_SB(0, 0), cB, voffB); PG8_STAGE(PG8_SA(0, 0), cA, voffA); PG8_STAGE(PG8_SB(0, 1), cB + hstep, voffB); PG8_STAGE(PG8_SA(0, 1), cA + hstep, voffA);
        if (wr == 1) PG8_BAR;
        PG8_WAIT_V(4); PG8_BAR;
        PG8_STAGE(PG8_SB(1, 0), cB + kstep, voffB); PG8_STAGE(PG8_SA(1, 0), cA + kstep, voffA); PG8_STAGE(PG8_SB(1, 1), cB + hstep + kstep, voffB);
        PG8_WAIT_V(6); PG8_BAR;
    }
    for (;;) {
        const bool has_next = S.next(ui + 1, nxt);
        const char* nA = has_next ? (const char*)g.A + (size_t)nxt.pm * tstep : cA; const char* nB = has_next ? (const char*)g.Bt + (size_t)nxt.pn * tstep : cB;
        for (int t = 0; t < nt; t += 2) {
            const bool last = (t == nt - 2);
            const char* a1 = cA + (size_t)(t + 1) * kstep;
            const char* a2 = last ? nA : cA + (size_t)(t + 2) * kstep; const char* b2 = last ? nB : cB + (size_t)(t + 2) * kstep;
            const char* a3 = a2 + kstep; const char* b3 = b2 + kstep;
            if (last && has_next) S.a_ready(nxt);
            if constexpr (SP2) {
            PG8_LDB(B0, 0, 0); PG8_LDB(B1, 0, 1); PG8_SCHED; PG8_LDA(At, 0, 0); PG8_STAGE(PG8_SA(1, 1), a1 + hstep, voffA);
            PG8_WAIT_V(8); PG8_WAIT_L(0); PG8_BAR; PG8_MMA(0, 0, At, B0); PG8_MMA(0, 1, At, B1); PG8_BAR; PG8_SCHED;
            PG8_LDA(At, 0, 1); PG8_STAGE(PG8_SB(0, 0), b2, voffB); PG8_STAGE(PG8_SB(0, 1), b2 + hstep, voffB); PG8_STAGE(PG8_SA(0, 0), a2, voffA);
            PG8_WAIT_V(8); PG8_WAIT_L(0); PG8_BAR; PG8_MMA(1, 0, At, B0); PG8_MMA(1, 1, At, B1); PG8_BAR; PG8_SCHED;
            PG8_LDB(B0, 1, 0); PG8_LDB(B1, 1, 1); PG8_SCHED; PG8_LDA(At, 1, 0); PG8_STAGE(PG8_SA(0, 1), a2 + hstep, voffA);
            PG8_WAIT_V(8); PG8_WAIT_L(0); PG8_BAR; PG8_MMA(0, 0, At, B0); PG8_MMA(0, 1, At, B1); PG8_BAR; PG8_SCHED;
            PG8_LDA(At, 1, 1); PG8_STAGE(PG8_SB(1, 0), b3, voffB); PG8_STAGE(PG8_SB(1, 1), b3 + hstep, voffB); PG8_STAGE(PG8_SA(1, 0), a3, voffA);
            PG8_WAIT_V(8); PG8_WAIT_L(0); PG8_BAR; PG8_MMA(1, 0, At, B0); PG8_MMA(1, 1, At, B1); PG8_BAR; PG8_SCHED;
            } else {
            PG8_LDB(B0, 0, 0); PG8_SCHED; PG8_LDA(At, 0, 0); PG8_STAGE(PG8_SA(1, 1), a1 + hstep, voffA);
            PG8_WAIT_L(8); PG8_BAR; PG8_WAIT_L(0); PG8_MMA(0, 0, At, B0); PG8_BAR; PG8_SCHED;
            PG8_LDB(B1, 0, 1); PG8_STAGE(PG8_SB(0, 0), b2, voffB);
            PG8_BAR; PG8_WAIT_L(0); PG8_MMA(0, 1, At, B1); PG8_BAR;
            PG8_LDA(At, 0, 1); PG8_STAGE(PG8_SA(0, 0), a2, voffA);
            PG8_BAR; PG8_WAIT_L(0); PG8_MMA(1, 0, At, B0); PG8_BAR; PG8_SCHED;
            PG8_STAGE(PG8_SB(0, 1), b2 + hstep, voffB);
            PG8_WAIT_V(6); PG8_BAR; PG8_MMA(1, 1, At, B1); PG8_BAR;
            PG8_LDB(B0, 1, 0); PG8_SCHED; PG8_LDA(At, 1, 0); PG8_STAGE(PG8_SA(0, 1), a2 + hstep, voffA);
            PG8_WAIT_L(8); PG8_BAR; PG8_WAIT_L(0); PG8_MMA(0, 0, At, B0); PG8_BAR; PG8_SCHED;
            PG8_LDB(B1, 1, 1); PG8_STAGE(PG8_SB(1, 0), b3, voffB);
            PG8_BAR; PG8_WAIT_L(0); PG8_MMA(0, 1, At, B1); PG8_BAR;
            PG8_LDA(At, 1, 1); PG8_STAGE(PG8_SA(1, 0), a3, voffA);
            PG8_BAR; PG8_WAIT_L(0); PG8_MMA(1, 0, At, B0); PG8_BAR; PG8_SCHED;
            PG8_STAGE(PG8_SB(1, 1), b3 + hstep, voffB);
            PG8_WAIT_V(6); PG8_BAR; PG8_MMA(1, 1, At, B1); PG8_BAR;
            }
        }
        if constexpr (ALIGN_EPI) { if (wr == 0) PG8_BAR; }
        if constexpr (!Epi::AFTER_DRAIN) { E(acc, cur, wr, wc, fr, fq); S.done(cur); }
        if (!has_next) break;
#pragma unroll
        for (int a = 0; a < 2; ++a)
#pragma unroll
            for (int b = 0; b < 2; ++b)
#pragma unroll
                for (int m = 0; m < 4; ++m)
#pragma unroll
                    for (int n = 0; n < 2; ++n) acc[a][b][m][n] = (f32x4){0.f, 0.f, 0.f, 0.f};
        cur = nxt; cA = nA; cB = nB; ++ui;
        if constexpr (ALIGN_EPI) { if (wr == 1) PG8_BAR; }
    }
    PG8_WAIT_V(0);
    if constexpr (!ALIGN_EPI) { if (wr == 0) PG8_BAR; }
    PG8_BAR;
    if constexpr (Epi::AFTER_DRAIN) { E.fused(acc, cur, wr, wc, fr, fq, lds, wid, lane); S.done(cur); }
#undef PG8_SA
#undef PG8_SB
#undef PG8_STAGE
#undef PG8_LDA
#undef PG8_LDB
#undef PG8_MMA
#undef PG8_WAIT_V
#undef PG8_WAIT_L
#undef PG8_BAR
#undef PG8_SCHED
}
}

#define GAS __attribute__((address_space(1)))
#define LAS __attribute__((address_space(3)))
typedef unsigned short bf16;
typedef unsigned v4u __attribute__((ext_vector_type(4)));
typedef unsigned v2u __attribute__((ext_vector_type(2)));
typedef float f32x4 __attribute__((ext_vector_type(4)));
typedef GAS unsigned gu32;
#define LDS_WAIT() asm volatile("s_waitcnt lgkmcnt(0)" ::: "memory")
#define VM_WAIT() asm volatile("s_waitcnt vmcnt(0)" ::: "memory")
__device__ __forceinline__ unsigned f2bf(float f) { unsigned u = __builtin_bit_cast(unsigned, f); return (u + 0x7fffu + ((u >> 16) & 1u)) >> 16; }
__device__ __forceinline__ unsigned pk2(float lo, float hi) { return f2bf(lo) | (f2bf(hi) << 16); }
__device__ __forceinline__ float bf2f(unsigned short b) { return __builtin_bit_cast(float, (unsigned)b << 16); }
__device__ __forceinline__ float bflo(unsigned w) { return __builtin_bit_cast(float, w << 16); }
__device__ __forceinline__ float bfhi(unsigned w) { return __builtin_bit_cast(float, w & 0xffff0000u); }
__device__ __forceinline__ float wave_sum(float v) {
#pragma unroll
    for (int o = 1; o < 64; o <<= 1) v += __shfl_xor(v, o);
    return v;
}
__device__ __forceinline__ float silu_f(float x) { return x * __builtin_amdgcn_rcpf(1.0f + __expf(-x)); }
__device__ __forceinline__ float sigmoid_f(float x) { return __builtin_amdgcn_rcpf(1.0f + __expf(-x)); }
__device__ __forceinline__ float softplus_f(float z) { return z > 0.f ? z + log1pf(expf(-z)) : log1pf(expf(z)); }
__device__ __forceinline__ float gelu_tanh_f(float x) { const float u = 0.7978845608028654f * (x + 0.044715f * x * x * x); const float t = 1.0f - 2.0f * __builtin_amdgcn_rcpf(__expf(2.0f * u) + 1.0f); return 0.5f * x * (1.0f + t); }

#define XB_TMO      128
#define XB_XCNT(j)  (256  + 64 * (j))
#define XB_XSUB(j)  (1280 + 64 * (j))
#define XB_XGEN(j)  (2304 + 64 * (j))
#define XB_TOP      3328
#define XB_TOPGEN   3392
#define XCD_BAR_WORDS 3456
#define XB_SPIN_CAP (1u << 18)

__device__ __forceinline__ unsigned xb_ld(unsigned* p)              { return __hip_atomic_load(p, __ATOMIC_RELAXED, __HIP_MEMORY_SCOPE_AGENT); }
__device__ __forceinline__ unsigned xb_add(unsigned* p, unsigned v) { return __hip_atomic_fetch_add(p, v, __ATOMIC_RELAXED, __HIP_MEMORY_SCOPE_AGENT); }
__device__ __forceinline__ unsigned xb_xcc_id() { return (unsigned)__builtin_amdgcn_s_getreg((3 << 11) | 20) & 0xFu; }
#define XB_SPIN(cond, bar) do { unsigned _sp = 0; while (cond) { __builtin_amdgcn_s_sleep(1); \
    if ((++_sp & 255u) == 0u) { if (xb_ld(&(bar)[XB_TMO])) break; if (_sp > XB_SPIN_CAP) { atomicAdd(&(bar)[XB_TMO], 1u); break; } } } } while (0)

struct XcdBarrier {
    unsigned* bar; unsigned x;
    volatile LAS unsigned* st;
};

__device__ __forceinline__ XcdBarrier xcd_barrier_post(unsigned* bar, volatile LAS unsigned* st) {
    XcdBarrier b; b.bar = bar; b.x = xb_xcc_id(); b.st = st;
    if (threadIdx.x == 0) (void)xb_add(&bar[XB_XCNT(b.x)], 1u);
    return b;
}
__device__ __forceinline__ void xcd_barrier_complete(unsigned* bar, unsigned x, unsigned& nloc, unsigned& nx) {
    const unsigned G = gridDim.x * gridDim.y * gridDim.z;
    unsigned sum, cnt, mine, sp = 0u;
    for (;;) {
        sum = 0u; cnt = 0u; mine = 0u;
#pragma unroll
        for (unsigned j = 0; j < 16; ++j) { const unsigned c = xb_ld(&bar[XB_XCNT(j)]); sum += c; cnt += (c > 0u) ? 1u : 0u; mine = (j == x) ? c : mine; }
        if (sum == G) break;
        __builtin_amdgcn_s_sleep(1);
        if ((++sp & 255u) == 0u) { if (xb_ld(&bar[XB_TMO])) break; if (sp > XB_SPIN_CAP) { atomicAdd(&bar[XB_TMO], 1u); break; } }
    }
    nloc = mine > 0u ? mine : 1u; nx = cnt > 0u ? cnt : 1u;
}

__device__ __forceinline__ void xcd_barrier(const XcdBarrier& b) {
    asm volatile("s_waitcnt vmcnt(0)" ::: "memory");
    __syncthreads();
    if (threadIdx.x == 0) {
        unsigned* bar = b.bar;
        __builtin_amdgcn_s_waitcnt(0);
        unsigned nloc = b.st[0], nx = b.st[1];
        if (nloc == 0u) { xcd_barrier_complete(bar, b.x, nloc, nx); b.st[0] = nloc; b.st[1] = nx; }
        const unsigned old = xb_add(&bar[XB_XSUB(b.x)], 1u);
        const unsigned gen = old / nloc;
        if (old + 1u == (gen + 1u) * nloc) {
            __builtin_amdgcn_fence(__ATOMIC_RELEASE, "agent");
            asm volatile("s_waitcnt vmcnt(0)" ::: "memory");
            const unsigned og = xb_add(&bar[XB_TOP], 1u);
            const unsigned tg = og / nx;
            if (og + 1u == (tg + 1u) * nx) xb_add(&bar[XB_TOPGEN], 1u);
            else XB_SPIN(xb_ld(&bar[XB_TOPGEN]) == tg, bar);
            __builtin_amdgcn_fence(__ATOMIC_ACQUIRE, "agent");
            xb_add(&bar[XB_XGEN(b.x)], 1u);
            asm volatile("s_waitcnt vmcnt(0)" ::: "memory");
        } else {
            XB_SPIN(xb_ld(&bar[XB_XGEN(b.x)]) == gen, bar);
            __builtin_amdgcn_fence(__ATOMIC_ACQUIRE, "agent");
            asm volatile("s_waitcnt vmcnt(0)" ::: "memory");
        }
    }
    __syncthreads();
}

struct Params { const float* in[N_IN]; float* out; unsigned char* ws; int ph_lo, ph_hi; };
#define WSP(T, off) ((T*)(P.ws + (off)))
struct Ctx {
    LAS unsigned char* lds; int tid, lane, wave, G, gw, NGW;
};
__device__ __forceinline__ int prow(int b, int tt) { return tt < NMETA ? ROW_M + tt : b * SEQ + tt - NMETA; }

template <int MODE> __device__ __forceinline__ int dest_row(int n) {
    if (MODE == 1) return (n >> 4) * 32 + (n & 15);
    if (MODE == 2) return (n >> 4) * 32 + 16 + (n & 15);
    if (MODE == 3) return n < 2560 ? n : (n < 2576 ? -1 : n - 16);
    return n;
}
template <int MODE> __device__ __forceinline__ void transpose_item(const float* W, int K, int N, const float* gk, int gsplit, bf16* WT, LAS float* scr, int item, int lane) {
    const int nblk = (N + 31) / 32, kb = item / nblk, nb = item % nblk, k0 = 64 * kb, n0 = 32 * nb;
    const int col = n0 + (lane & 31);
#pragma unroll 8
    for (int i = 0; i < 32; ++i) { const int kk = 2 * i + (lane >> 5); const int k = k0 + kk;
        float v = col < N ? W[(size_t)k * N + col] : 0.f; if (gk != nullptr && k < gsplit) v *= gk[k];
        scr[kk * 33 + (lane & 31)] = v; }
    LDS_WAIT(); asm volatile("" ::: "memory");
    const int c = lane & 7;
#pragma unroll
    for (int j = 0; j < 4; ++j) { const int n = (lane >> 3) + 8 * j; const LAS float* s = scr + (8 * c) * 33 + n; const int dr = dest_row<MODE>(n0 + n);
        if (n0 + n < N && dr >= 0) { v4u o; o.x = pk2(s[0 * 33], s[1 * 33]); o.y = pk2(s[2 * 33], s[3 * 33]); o.z = pk2(s[4 * 33], s[5 * 33]); o.w = pk2(s[6 * 33], s[7 * 33]);
            *(v4u*)(WT + (size_t)dr * K + k0 + 8 * c) = o; } }
    LDS_WAIT(); asm volatile("" ::: "memory");
}
__device__ __forceinline__ void p0_prologue(const Params& P, const Ctx& C) {
    LAS float* scr = (LAS float*)(C.lds + C.wave * 16384);
    constexpr int I_GU = (D / 64) * (DFF / 32), I_D = (DFF / 64) * (D / 32), I_IN = (D / 64) * ((INCOLS + 31) / 32), I_OUT = (DMIX / 64) * (D / 32);
    constexpr int PER_L = 4 * I_GU + 2 * I_D + I_IN + I_OUT;
    for (int it = C.gw; it < DEPTH * PER_L; it += C.NGW) {
        const int l = it / PER_L; int r = it % PER_L;
        if (r < I_GU) { transpose_item<1>(P.in[I_F1WG] + (size_t)l * D * DFF, D, DFF, P.in[I_F1PRE] + l * D, D, WSP(bf16, WS_WGU1) + (size_t)l * NGU * D, scr, r, C.lane); continue; } r -= I_GU;
        if (r < I_GU) { transpose_item<2>(P.in[I_F1WU] + (size_t)l * D * DFF, D, DFF, P.in[I_F1PRE] + l * D, D, WSP(bf16, WS_WGU1) + (size_t)l * NGU * D, scr, r, C.lane); continue; } r -= I_GU;
        if (r < I_GU) { transpose_item<1>(P.in[I_F2WG] + (size_t)l * D * DFF, D, DFF, P.in[I_F2PRE] + l * D, D, WSP(bf16, WS_WGU2) + (size_t)l * NGU * D, scr, r, C.lane); continue; } r -= I_GU;
        if (r < I_GU) { transpose_item<2>(P.in[I_F2WU] + (size_t)l * D * DFF, D, DFF, P.in[I_F2PRE] + l * D, D, WSP(bf16, WS_WGU2) + (size_t)l * NGU * D, scr, r, C.lane); continue; } r -= I_GU;
        if (r < I_D) { transpose_item<0>(P.in[I_F1WD] + (size_t)l * DFF * D, DFF, D, nullptr, 0, WSP(bf16, WS_WD1) + (size_t)l * D * DFF, scr, r, C.lane); continue; } r -= I_D;
        if (r < I_D) { transpose_item<0>(P.in[I_F2WD] + (size_t)l * DFF * D, DFF, D, nullptr, 0, WSP(bf16, WS_WD2) + (size_t)l * D * DFF, scr, r, C.lane); continue; } r -= I_D;
        if (r < I_IN) { transpose_item<3>(P.in[I_WIN] + (size_t)l * D * INCOLS, D, INCOLS, P.in[I_MPRE] + l * D, D, WSP(bf16, WS_WIN) + (size_t)l * NIN * D, scr, r, C.lane); continue; } r -= I_IN;
        transpose_item<0>(P.in[I_WOUT] + (size_t)l * DMIX * D, DMIX, D, P.in[I_SSDG] + l * D, D, WSP(bf16, WS_WOUT) + (size_t)l * D * DMIX, scr, r, C.lane);
    }
    for (int i = C.gw * 64 + C.lane; i < DEPTH * 16 * D; i += C.NGW * 64) { const int l = i / (16 * D), j = (i / D) % 16, k = i % D;
        WSP(float, WS_WDT)[i] = P.in[I_WIN][(size_t)l * D * INCOLS + (size_t)k * INCOLS + 2560 + j] * P.in[I_MPRE][l * D + k]; }
    for (int r = C.gw; r < MP; r += C.NGW) {
        const float* src = r < ROW_S ? P.in[I_XP] + (size_t)r * D : (r < ROW_M ? P.in[I_XS] + (size_t)(r - ROW_S) * D : (r < NROWS ? P.in[I_META] + (size_t)(r - ROW_M) * D : nullptr));
        f32x4 v[4]; float s = 0.f;
#pragma unroll
        for (int j = 0; j < 4; ++j) { v[j] = src ? ((const f32x4*)src)[C.lane + 64 * j] : (f32x4){0.f, 0.f, 0.f, 0.f}; s += (v[j].x * v[j].x + v[j].y * v[j].y) + (v[j].z * v[j].z + v[j].w * v[j].w); }
        const float rs = rsqrtf(wave_sum(s) * (1.f / D) + EPS);
#pragma unroll
        for (int j = 0; j < 4; ++j) { ((f32x4*)(WSP(float, WS_X) + (size_t)r * D))[C.lane + 64 * j] = v[j];
            v2u o; o.x = pk2(v[j].x * rs, v[j].y * rs); o.y = pk2(v[j].z * rs, v[j].w * rs); ((v2u*)(WSP(bf16, WS_XB) + (size_t)r * D))[C.lane + 64 * j] = o; }
    }
}

__device__ __forceinline__ void rn_phase(const Params& P, const Ctx& C, float cc, const float* gpost, bool do_dt, int l, bool fin) {
    LAS float* wl = (LAS float*)C.lds;
    if (do_dt) { for (int i = C.tid; i < 16 * D / 4; i += NTHR) ((LAS f32x4*)wl)[i] = ((const f32x4*)(WSP(float, WS_WDT) + (size_t)l * 16 * D))[i]; __syncthreads(); }
    for (int r = C.gw; r < NROWS; r += C.NGW) {
        f32x4 v[4]; float s = 0.f;
#pragma unroll
        for (int j = 0; j < 4; ++j) { v[j] = ((const f32x4*)(WSP(float, WS_Y) + (size_t)r * D))[C.lane + 64 * j]; s += (v[j].x * v[j].x + v[j].y * v[j].y) + (v[j].z * v[j].z + v[j].w * v[j].w); }
        const float rs = rsqrtf(wave_sum(s) * (1.f / D) + EPS) * cc; float s2 = 0.f;
#pragma unroll
        for (int j = 0; j < 4; ++j) { const f32x4 g = ((const f32x4*)gpost)[C.lane + 64 * j], x0 = ((const f32x4*)(WSP(float, WS_X) + (size_t)r * D))[C.lane + 64 * j];
            v[j] = x0 + v[j] * rs * g; s2 += (v[j].x * v[j].x + v[j].y * v[j].y) + (v[j].z * v[j].z + v[j].w * v[j].w); }
        const float rs2 = rsqrtf(wave_sum(s2) * (1.f / D) + EPS);
        if (fin) { if (r < ROW_M) {
#pragma unroll
            for (int j = 0; j < 4; ++j) ((f32x4*)(P.out + (size_t)r * D))[C.lane + 64 * j] = v[j]; } }
        else {
#pragma unroll
            for (int j = 0; j < 4; ++j) { ((f32x4*)(WSP(float, WS_X) + (size_t)r * D))[C.lane + 64 * j] = v[j];
                v2u o; o.x = pk2(v[j].x * rs2, v[j].y * rs2); o.y = pk2(v[j].z * rs2, v[j].w * rs2); ((v2u*)(WSP(bf16, WS_XB) + (size_t)r * D))[C.lane + 64 * j] = o; }
        }
        if (do_dt) { float mine = 0.f;
#pragma unroll 1
            for (int j16 = 0; j16 < 16; ++j16) { float a = 0.f;
#pragma unroll
                for (int j = 0; j < 4; ++j) { const f32x4 w = ((const LAS f32x4*)(wl + j16 * D))[C.lane + 64 * j]; a += (v[j].x * w.x + v[j].y * w.y) + (v[j].z * w.z + v[j].w * w.w); }
                a = wave_sum(a); if (C.lane == j16) mine = a; }
            if (C.lane < 16) WSP(float, WS_DT)[(size_t)r * 16 + C.lane] = softplus_f(mine * rs2 + P.in[I_DTB][l * 16 + C.lane]); }
    }
}

__device__ __forceinline__ void conv_phase(const Params& P, const Ctx& C, int l) {
    const size_t gt = (size_t)C.gw * 64 + C.lane, NT = (size_t)C.NGW * 64;
    const float* cw = P.in[I_CONVW] + (size_t)l * 4 * XBCW; const float* cb = P.in[I_CONVB] + (size_t)l * XBCW;
    for (size_t idx = gt; idx < (size_t)NROWS * (XBCW / 8); idx += NT) {
        const int r = (int)(idx / (XBCW / 8)), ch = (int)(idx % (XBCW / 8)) * 8;
        float acc[8];
        { const f32x4 b0 = *(const f32x4*)(cb + ch), b1 = *(const f32x4*)(cb + ch + 4); acc[0] = b0.x; acc[1] = b0.y; acc[2] = b0.z; acc[3] = b0.w; acc[4] = b1.x; acc[5] = b1.y; acc[6] = b1.z; acc[7] = b1.w; }
#pragma unroll
        for (int k = 0; k < 4; ++k) {
            int srow = -1; const float* fsrc = nullptr;
            if (r < ROW_S) { const int t = r & (SEQ - 1), tp = t - 3 + k; srow = tp >= 0 ? r - 3 + k : ROW_M + NMETA + tp; }
            else if (r < ROW_M) { const int q = r - ROW_S, b = q >> 2, s = q & 3, pos = s - 3 + k; if (pos >= 0) srow = ROW_S + 4 * b + pos; else fsrc = P.in[I_SSDCONV] + ((size_t)(l * NSB + b) * 3 + (3 + pos)) * XBCW + ch; }
            else { const int pos = (r - ROW_M) - 3 + k; if (pos >= 0) srow = ROW_M + pos; }
            float xv[8];
            if (srow >= 0) { const v4u w = *(const v4u*)(WSP(bf16, WS_PROJ) + (size_t)srow * NIN + PX + ch); xv[0] = bflo(w.x); xv[1] = bfhi(w.x); xv[2] = bflo(w.y); xv[3] = bfhi(w.y); xv[4] = bflo(w.z); xv[5] = bfhi(w.z); xv[6] = bflo(w.w); xv[7] = bfhi(w.w); }
            else if (fsrc) { const f32x4 a0 = *(const f32x4*)fsrc, a1 = *(const f32x4*)(fsrc + 4); xv[0] = a0.x; xv[1] = a0.y; xv[2] = a0.z; xv[3] = a0.w; xv[4] = a1.x; xv[5] = a1.y; xv[6] = a1.z; xv[7] = a1.w; }
            else {
#pragma unroll
                for (int e = 0; e < 8; ++e) xv[e] = 0.f; }
            const f32x4 w0 = *(const f32x4*)(cw + (size_t)k * XBCW + ch), w1 = *(const f32x4*)(cw + (size_t)k * XBCW + ch + 4);
            acc[0] += w0.x * xv[0]; acc[1] += w0.y * xv[1]; acc[2] += w0.z * xv[2]; acc[3] += w0.w * xv[3]; acc[4] += w1.x * xv[4]; acc[5] += w1.y * xv[5]; acc[6] += w1.z * xv[6]; acc[7] += w1.w * xv[7];
        }
        v4u o; o.x = pk2(silu_f(acc[0]), silu_f(acc[1])); o.y = pk2(silu_f(acc[2]), silu_f(acc[3])); o.z = pk2(silu_f(acc[4]), silu_f(acc[5])); o.w = pk2(silu_f(acc[6]), silu_f(acc[7]));
        *(v4u*)(WSP(bf16, WS_XBCC) + (size_t)r * XBCW + ch) = o;
    }
    for (size_t i = gt; i < (size_t)NPB * 3 * XBCW; i += NT) { const int b = (int)(i / (3 * XBCW)), j = (int)(i / XBCW) % 3, ch = (int)(i % XBCW);
        P.out[O_CONVP + (size_t)l * NPB * 3 * XBCW + i] = bf2f(WSP(bf16, WS_PROJ)[(size_t)(b * SEQ + SEQ - 3 + j) * NIN + PX + ch]); }
    for (size_t i = gt; i < (size_t)NPB * 3 * D; i += NT) { const int b = (int)(i / (3 * D)), j = (int)(i / D) % 3, ch = (int)(i % D);
        P.out[O_LCONVP + (size_t)l * NPB * 3 * D + i] = bf2f(WSP(bf16, WS_PROJ)[(size_t)(b * SEQ + SEQ - 3 + j) * NIN + PXR + ch]); }
    for (size_t i = gt; i < (size_t)NSB * 3 * XBCW; i += NT) { const int b = (int)(i / (3 * XBCW)), j = (int)(i / XBCW) % 3, ch = (int)(i % XBCW);
        P.out[O_CONVS + (size_t)l * NSB * 3 * XBCW + i] = bf2f(WSP(bf16, WS_PROJ)[(size_t)(ROW_S + 4 * b + 1 + j) * NIN + PX + ch]); }
    for (size_t i = gt; i < (size_t)NSB * 3 * D; i += NT) { const int b = (int)(i / (3 * D)), j = (int)(i / D) % 3, ch = (int)(i % D);
        P.out[O_LCONVS + (size_t)l * NSB * 3 * D + i] = bf2f(WSP(bf16, WS_PROJ)[(size_t)(ROW_S + 4 * b + 1 + j) * NIN + PXR + ch]); }
}

__device__ __forceinline__ void ssd_prompt_naive(const Params& P, const Ctx& C, int l, int b, int h) {
    const int tid = C.tid, p = tid >> 3, ng = tid & 7, g = h >> 3;
    LAS bf16* Bs = (LAS bf16*)C.lds; LAS bf16* Cs = (LAS bf16*)(C.lds + 16384); LAS bf16* Xs = (LAS bf16*)(C.lds + 32768);
    LAS float* dts = (LAS float*)(C.lds + 40960); LAS int* rws = (LAS int*)(C.lds + 41216); LAS float* yb = (LAS float*)(C.lds + 41472);
    float S[16];
#pragma unroll
    for (int i = 0; i < 16; ++i) S[i] = 0.f;
    const float a = -expf(P.in[I_ALOG][l * 16 + h]), Dh = P.in[I_SSDD][l * 16 + h];
    float* ssq = (WSP(float, WS_CTL) + CW_SSQ) + (size_t)l * MP;
    for (int c0 = 0; c0 < SEQ + NMETA; c0 += 64) {
        const int nv = (SEQ + NMETA - c0) < 64 ? (SEQ + NMETA - c0) : 64;
        { const int tl = tid >> 3, part = tid & 7;
          if (tl < nv) { const int row = prow(b, c0 + tl); const bf16* src = WSP(bf16, WS_XBCC) + (size_t)row * XBCW;
              *(LAS v4u*)(Bs + tl * 128 + part * 16) = *(const v4u*)(src + 1024 + g * 128 + part * 16); *(LAS v4u*)(Bs + tl * 128 + part * 16 + 8) = *(const v4u*)(src + 1024 + g * 128 + part * 16 + 8);
              *(LAS v4u*)(Cs + tl * 128 + part * 16) = *(const v4u*)(src + 1280 + g * 128 + part * 16); *(LAS v4u*)(Cs + tl * 128 + part * 16 + 8) = *(const v4u*)(src + 1280 + g * 128 + part * 16 + 8);
              *(LAS v4u*)(Xs + tl * 64 + part * 8) = *(const v4u*)(src + h * 64 + part * 8);
              if (part == 0) { dts[tl] = WSP(float, WS_DT)[(size_t)row * 16 + h]; rws[tl] = row; } } }
        __syncthreads();
        for (int tl = 0; tl < nv; ++tl) {
            const float dt = dts[tl], dA = __expf(dt * a), x = bf2f(Xs[tl * 64 + p]), dtx = dt * x;
            const v4u b0 = *(const LAS v4u*)(Bs + tl * 128 + ng * 16), b1 = *(const LAS v4u*)(Bs + tl * 128 + ng * 16 + 8), c0v = *(const LAS v4u*)(Cs + tl * 128 + ng * 16), c1v = *(const LAS v4u*)(Cs + tl * 128 + ng * 16 + 8);
            float acc = 0.f;
#pragma unroll
            for (int w = 0; w < 4; ++w) { const unsigned bw = b0[w], cwd = c0v[w];
                S[2 * w] = dA * S[2 * w] + dtx * bflo(bw); acc += S[2 * w] * bflo(cwd); S[2 * w + 1] = dA * S[2 * w + 1] + dtx * bfhi(bw); acc += S[2 * w + 1] * bfhi(cwd); }
#pragma unroll
            for (int w = 0; w < 4; ++w) { const unsigned bw = b1[w], cwd = c1v[w];
                S[8 + 2 * w] = dA * S[8 + 2 * w] + dtx * bflo(bw); acc += S[8 + 2 * w] * bflo(cwd); S[8 + 2 * w + 1] = dA * S[8 + 2 * w + 1] + dtx * bfhi(bw); acc += S[8 + 2 * w + 1] * bfhi(cwd); }
            acc += __shfl_xor(acc, 1); acc += __shfl_xor(acc, 2); acc += __shfl_xor(acc, 4);
            if (ng == 0) yb[tl * 64 + p] = acc + Dh * x;
        }
        __syncthreads();
        { const int tl = tid >> 3, pp = (tid & 7) * 8; float sq = 0.f; int row = 0;
          const bool act = tl < nv && (b == 0 || c0 + tl >= NMETA);
          if (act) { row = rws[tl]; const v4u z = *(const v4u*)(WSP(bf16, WS_PROJ) + (size_t)row * NIN + PZ + h * 64 + pp); float y[8];
              y[0] = yb[tl * 64 + pp + 0] * silu_f(bflo(z.x)); y[1] = yb[tl * 64 + pp + 1] * silu_f(bfhi(z.x)); y[2] = yb[tl * 64 + pp + 2] * silu_f(bflo(z.y)); y[3] = yb[tl * 64 + pp + 3] * silu_f(bfhi(z.y));
              y[4] = yb[tl * 64 + pp + 4] * silu_f(bflo(z.z)); y[5] = yb[tl * 64 + pp + 5] * silu_f(bfhi(z.z)); y[6] = yb[tl * 64 + pp + 6] * silu_f(bflo(z.w)); y[7] = yb[tl * 64 + pp + 7] * silu_f(bfhi(z.w));
#pragma unroll
              for (int e = 0; e < 8; ++e) sq += y[e] * y[e];
              v4u o; o.x = pk2(y[0], y[1]); o.y = pk2(y[2], y[3]); o.z = pk2(y[4], y[5]); o.w = pk2(y[6], y[7]);
              *(v4u*)(WSP(bf16, WS_YMIX) + (size_t)row * DMIX + h * 64 + pp) = o; }
          sq += __shfl_xor(sq, 1); sq += __shfl_xor(sq, 2); sq += __shfl_xor(sq, 4);
          if (act && (tid & 7) == 0) atomicAdd(ssq + row, sq); }
        __syncthreads();
    }
    float* o = P.out + O_SSDP + (((size_t)(l * NPB + b) * 16 + h) * 64 + p) * 128 + ng * 16;
#pragma unroll
    for (int i = 0; i < 4; ++i) ((f32x4*)o)[i] = (f32x4){S[4 * i], S[4 * i + 1], S[4 * i + 2], S[4 * i + 3]};
}

constexpr int SRS = 136;
constexpr int SSD_CS = 0, SSD_BS = 34816, SSD_BT = 69632, SSD_XT = 104448, SSD_SS = 121856, SSD_SM = 139264, SSD_END = SSD_SM + 1536;
static_assert(SSD_END <= LDS_BYTES - 256, "SSD LDS map");
__device__ __forceinline__ unsigned cvtpk(float lo, float hi) { unsigned r; asm volatile("v_cvt_pk_bf16_f32 %0, %1, %2" : "=v"(r) : "v"(lo), "v"(hi)); return r; }
__device__ __forceinline__ void ssd_prompt_mfma(const Params& P, const Ctx& C, int l, int b, int h) {
    typedef pg8::bf16x8 bf16x8;
    const int tid = C.tid, lane = C.lane, w = C.wave, l15 = lane & 15, q = lane >> 4, g = h >> 3;
    LAS bf16* Cs = (LAS bf16*)(C.lds + SSD_CS); LAS bf16* Bs = (LAS bf16*)(C.lds + SSD_BS); LAS bf16* BT = (LAS bf16*)(C.lds + SSD_BT); LAS bf16* XT = (LAS bf16*)(C.lds + SSD_XT); LAS bf16* Ss = (LAS bf16*)(C.lds + SSD_SS);
    LAS float* dts = (LAS float*)(C.lds + SSD_SM); LAS float* cums = dts + 128; LAS int* rws = (LAS int*)(cums + 128);
    const float a = -expf(P.in[I_ALOG][l * 16 + h]), Dh = P.in[I_SSDD][l * 16 + h];
    const bf16* xbcc = WSP(bf16, WS_XBCC); const bf16* proj = WSP(bf16, WS_PROJ); bf16* ymix = WSP(bf16, WS_YMIX); const float* dtg = WSP(float, WS_DT);
    float* ssq = WSP(float, WS_CTL) + CW_SSQ + (size_t)l * MP;
    f32x4 S[4];
#pragma unroll
    for (int pt = 0; pt < 4; ++pt) S[pt] = (f32x4){0.f, 0.f, 0.f, 0.f};
    for (int i = tid; i < 64 * SRS * 2 / 16; i += NTHR) ((LAS v4u*)Ss)[i] = (v4u){0u, 0u, 0u, 0u};
#pragma unroll 1
    for (int ci = 0; ci < 17; ++ci) {
        const int tt0 = ci == 0 ? 0 : NMETA + 128 * (ci - 1), nvalid = ci == 0 ? NMETA : 128;
        { const int j = tid >> 2, part = tid & 3, jj = j < nvalid ? j : nvalid - 1; const bf16* src = xbcc + (size_t)prow(b, tt0 + jj) * XBCW;
#pragma unroll
          for (int e = 0; e < 4; ++e) { *(LAS v4u*)(Cs + j * SRS + part * 32 + 8 * e) = *(const v4u*)(src + 1280 + g * 128 + part * 32 + 8 * e); *(LAS v4u*)(Bs + j * SRS + part * 32 + 8 * e) = *(const v4u*)(src + 1024 + g * 128 + part * 32 + 8 * e); }
          const v4u x0 = *(const v4u*)(src + h * 64 + part * 16), x1 = *(const v4u*)(src + h * 64 + part * 16 + 8);
          LAS bf16* xt = XT + (part * 16) * SRS + j;
          xt[0 * SRS] = (bf16)(x0.x & 0xffffu); xt[1 * SRS] = (bf16)(x0.x >> 16); xt[2 * SRS] = (bf16)(x0.y & 0xffffu); xt[3 * SRS] = (bf16)(x0.y >> 16); xt[4 * SRS] = (bf16)(x0.z & 0xffffu); xt[5 * SRS] = (bf16)(x0.z >> 16); xt[6 * SRS] = (bf16)(x0.w & 0xffffu); xt[7 * SRS] = (bf16)(x0.w >> 16);
          xt[8 * SRS] = (bf16)(x1.x & 0xffffu); xt[9 * SRS] = (bf16)(x1.x >> 16); xt[10 * SRS] = (bf16)(x1.y & 0xffffu); xt[11 * SRS] = (bf16)(x1.y >> 16); xt[12 * SRS] = (bf16)(x1.z & 0xffffu); xt[13 * SRS] = (bf16)(x1.z >> 16); xt[14 * SRS] = (bf16)(x1.w & 0xffffu); xt[15 * SRS] = (bf16)(x1.w >> 16); }
        if (w == 0) { const int j0 = 2 * lane, j1 = 2 * lane + 1; const int r0 = prow(b, tt0 + (j0 < nvalid ? j0 : nvalid - 1)), r1 = prow(b, tt0 + (j1 < nvalid ? j1 : nvalid - 1));
            const float d0 = j0 < nvalid ? dtg[(size_t)r0 * 16 + h] : 0.f, d1 = j1 < nvalid ? dtg[(size_t)r1 * 16 + h] : 0.f;
            float s = (d0 + d1) * a;
#pragma unroll
            for (int o = 1; o < 64; o <<= 1) { const float t = __shfl_up(s, o); if (lane >= o) s += t; }
            dts[j0] = d0; dts[j1] = d1; cums[j0] = s - d1 * a; cums[j1] = s; rws[j0] = r0; rws[j1] = r1; }
        __syncthreads();
        const float cl = cums[127];
        { const int j = tid >> 2, part = tid & 3; const float wj = __expf(cl - cums[j]) * dts[j];
#pragma unroll
          for (int e = 0; e < 4; ++e) { const v4u bv = *(const LAS v4u*)(Bs + j * SRS + part * 32 + 8 * e); LAS bf16* bt = BT + (part * 32 + 8 * e) * SRS + j;
              bt[0 * SRS] = (bf16)f2bf(bflo(bv.x) * wj); bt[1 * SRS] = (bf16)f2bf(bfhi(bv.x) * wj); bt[2 * SRS] = (bf16)f2bf(bflo(bv.y) * wj); bt[3 * SRS] = (bf16)f2bf(bfhi(bv.y) * wj);
              bt[4 * SRS] = (bf16)f2bf(bflo(bv.z) * wj); bt[5 * SRS] = (bf16)f2bf(bfhi(bv.z) * wj); bt[6 * SRS] = (bf16)f2bf(bflo(bv.w) * wj); bt[7 * SRS] = (bf16)f2bf(bfhi(bv.w) * wj); } }
        bf16x8 Cf[4];
#pragma unroll
        for (int ks = 0; ks < 4; ++ks) Cf[ks] = *(const LAS bf16x8*)(Cs + (16 * w + l15) * SRS + ks * 32 + 8 * q);
        f32x4 G[8];
#pragma unroll
        for (int jb = 0; jb < 8; ++jb) { G[jb] = (f32x4){0.f, 0.f, 0.f, 0.f};
            if (jb <= w) {
#pragma unroll
                for (int ks = 0; ks < 4; ++ks) { const bf16x8 af = *(const LAS bf16x8*)(Bs + (16 * jb + l15) * SRS + ks * 32 + 8 * q); G[jb] = __builtin_amdgcn_mfma_f32_16x16x32_bf16(af, Cf[ks], G[jb], 0, 0, 0); } } }
        __syncthreads();
        const int irow = 16 * w + l15; const float cumi = cums[irow];
        LAS bf16* Ps = Bs;
#pragma unroll
        for (int jb = 0; jb < 8; ++jb) {
            if (jb <= w) { float pv[4];
#pragma unroll
                for (int r = 0; r < 4; ++r) { const int j = 16 * jb + 4 * q + r; const float e = __expf(cumi - cums[j]) * dts[j]; pv[r] = (j <= irow) ? G[jb][r] * e : 0.f; }
                *(LAS v2u*)(Ps + irow * SRS + 16 * jb + 4 * q) = (v2u){cvtpk(pv[0], pv[1]), cvtpk(pv[2], pv[3])}; }
            else if (jb == w + 1) *(LAS v2u*)(Ps + irow * SRS + 16 * jb + 4 * q) = (v2u){0u, 0u};
        }
        f32x4 Y2[4], Y3[4];
#pragma unroll
        for (int pt = 0; pt < 4; ++pt) { Y2[pt] = (f32x4){0.f, 0.f, 0.f, 0.f}; Y3[pt] = (f32x4){0.f, 0.f, 0.f, 0.f}; }
#pragma unroll
        for (int ks = 0; ks < 4; ++ks) {
            if (ks <= (w >> 1)) { const bf16x8 pf = *(const LAS bf16x8*)(Ps + irow * SRS + ks * 32 + 8 * q);
#pragma unroll
                for (int pt = 0; pt < 4; ++pt) { const bf16x8 xf = *(const LAS bf16x8*)(XT + (16 * pt + l15) * SRS + ks * 32 + 8 * q); Y2[pt] = __builtin_amdgcn_mfma_f32_16x16x32_bf16(xf, pf, Y2[pt], 0, 0, 0); } }
#pragma unroll
            for (int pt = 0; pt < 4; ++pt) { const bf16x8 sf = *(const LAS bf16x8*)(Ss + (16 * pt + l15) * SRS + ks * 32 + 8 * q); Y3[pt] = __builtin_amdgcn_mfma_f32_16x16x32_bf16(sf, Cf[ks], Y3[pt], 0, 0, 0); }
        }
        { const float ecum = __expf(cumi); const int row = rws[irow]; const bool valid = (ci > 0) || (irow < NMETA && b == 0); float sq = 0.f;
#pragma unroll
          for (int pt = 0; pt < 4; ++pt) { const int pc = h * 64 + 16 * pt + 4 * q;
              const v2u xv = *(const v2u*)(xbcc + (size_t)row * XBCW + pc), zv = *(const v2u*)(proj + (size_t)row * NIN + PZ + pc);
              const float y0 = (Y2[pt][0] + ecum * Y3[pt][0] + Dh * bflo(xv.x)) * silu_f(bflo(zv.x)), y1 = (Y2[pt][1] + ecum * Y3[pt][1] + Dh * bfhi(xv.x)) * silu_f(bfhi(zv.x));
              const float y2 = (Y2[pt][2] + ecum * Y3[pt][2] + Dh * bflo(xv.y)) * silu_f(bflo(zv.y)), y3 = (Y2[pt][3] + ecum * Y3[pt][3] + Dh * bfhi(xv.y)) * silu_f(bfhi(zv.y));
              sq += (y0 * y0 + y1 * y1) + (y2 * y2 + y3 * y3);
              if (valid) *(v2u*)(ymix + (size_t)row * DMIX + pc) = (v2u){cvtpk(y0, y1), cvtpk(y2, y3)}; }
          sq += __shfl_xor(sq, 16); sq += __shfl_xor(sq, 32);
          if (valid && q == 0) atomicAdd(ssq + row, sq); }
        __syncthreads();
        { const float dec = __expf(cl);
#pragma unroll
          for (int pt = 0; pt < 4; ++pt) S[pt] = S[pt] * dec;
#pragma unroll
          for (int ks = 0; ks < 4; ++ks) { const bf16x8 bf = *(const LAS bf16x8*)(BT + (16 * w + l15) * SRS + ks * 32 + 8 * q);
#pragma unroll
              for (int pt = 0; pt < 4; ++pt) { const bf16x8 xf = *(const LAS bf16x8*)(XT + (16 * pt + l15) * SRS + ks * 32 + 8 * q); S[pt] = __builtin_amdgcn_mfma_f32_16x16x32_bf16(bf, xf, S[pt], 0, 0, 0); } }
#pragma unroll
          for (int pt = 0; pt < 4; ++pt) *(LAS v2u*)(Ss + (16 * pt + l15) * SRS + 16 * w + 4 * q) = (v2u){cvtpk(S[pt][0], S[pt][1]), cvtpk(S[pt][2], S[pt][3])}; }
        __syncthreads();
    }
#pragma unroll
    for (int pt = 0; pt < 4; ++pt) *(f32x4*)(P.out + O_SSDP + (((size_t)(l * NPB + b) * 16 + h) * 64 + 16 * pt + l15) * 128 + 16 * w + 4 * q) = S[pt];
}

__device__ __forceinline__ void ssd_sample_item(const Params& P, const Ctx& C, int l, int b, int h) {
    const int t2 = C.tid & 255, p = t2 >> 2, nq = t2 & 3, g = h >> 3;
    const float a = -expf(P.in[I_ALOG][l * 16 + h]), Dh = P.in[I_SSDD][l * 16 + h];
    const size_t soff = (((size_t)(l * NSB + b) * 16 + h) * 64 + p) * 128 + nq * 32;
    const float* sp = P.in[I_SSD] + soff;
    f32x4 S[8];
#pragma unroll
    for (int i = 0; i < 8; ++i) S[i] = ((const f32x4*)sp)[i];
    float* ssq = (WSP(float, WS_CTL) + CW_SSQ) + (size_t)l * MP;
#pragma unroll 1
    for (int s = 0; s < 4; ++s) {
        const int row = ROW_S + 4 * b + s; const bf16* src = WSP(bf16, WS_XBCC) + (size_t)row * XBCW;
        const float dt = WSP(float, WS_DT)[(size_t)row * 16 + h], dA = __expf(dt * a), x = bf2f(src[h * 64 + p]), dtx = dt * x;
        float acc = 0.f;
#pragma unroll
        for (int i = 0; i < 4; ++i) { const v4u bw = *(const v4u*)(src + 1024 + g * 128 + nq * 32 + 8 * i), cwv = *(const v4u*)(src + 1280 + g * 128 + nq * 32 + 8 * i);
            f32x4 s0 = S[2 * i], s1 = S[2 * i + 1];
            s0.x = dA * s0.x + dtx * bflo(bw.x); acc += s0.x * bflo(cwv.x); s0.y = dA * s0.y + dtx * bfhi(bw.x); acc += s0.y * bfhi(cwv.x);
            s0.z = dA * s0.z + dtx * bflo(bw.y); acc += s0.z * bflo(cwv.y); s0.w = dA * s0.w + dtx * bfhi(bw.y); acc += s0.w * bfhi(cwv.y);
            s1.x = dA * s1.x + dtx * bflo(bw.z); acc += s1.x * bflo(cwv.z); s1.y = dA * s1.y + dtx * bfhi(bw.z); acc += s1.y * bfhi(cwv.z);
            s1.z = dA * s1.z + dtx * bflo(bw.w); acc += s1.z * bflo(cwv.w); s1.w = dA * s1.w + dtx * bfhi(bw.w); acc += s1.w * bfhi(cwv.w);
            S[2 * i] = s0; S[2 * i + 1] = s1; }
        acc += __shfl_xor(acc, 1); acc += __shfl_xor(acc, 2);
        const float z = bf2f(WSP(bf16, WS_PROJ)[(size_t)row * NIN + PZ + h * 64 + p]);
        const float y = (acc + Dh * x) * silu_f(z);
        float sq = (nq == 0) ? y * y : 0.f;
        if (nq == 0) WSP(bf16, WS_YMIX)[(size_t)row * DMIX + h * 64 + p] = (bf16)f2bf(y);
        sq = wave_sum(sq);
        if (C.lane == 0) atomicAdd(ssq + row, sq);
    }
    float* o = P.out + O_SSDS + soff;
#pragma unroll
    for (int i = 0; i < 8; ++i) ((f32x4*)o)[i] = S[i];
}

template <bool SAMPLE> __device__ __forceinline__ void lru_item(const Params& P, const Ctx& C, int l, int sq, int k) {
    const int tid = C.tid, c = tid & 63, w = tid >> 6, ch = k * 64 + c;
    LAS float* XC = (LAS float*)C.lds; LAS float* AV = (LAS float*)(C.lds + 32768); LAS float* BV = (LAS float*)(C.lds + 65536);
    LAS float* SA = (LAS float*)(C.lds + 98304); LAS float* SB = (LAS float*)(C.lds + 98304 + 2048);
    const float* pa = P.in[I_LWA] + ((size_t)(l * 16 + k) * 64) * 64 + c; const float* px = P.in[I_LWX] + ((size_t)(l * 16 + k) * 64) * 64 + c;
    const float ba = P.in[I_LBA][l * D + ch], bx = P.in[I_LBX][l * D + ch], spl = softplus_f(-P.in[I_LLAM][l * D + ch]), cb = P.in[I_LCONVB][l * D + ch];
    float cwk[4];
#pragma unroll
    for (int kk = 0; kk < 4; ++kk) cwk[kk] = P.in[I_LCONVW][(size_t)(l * 4 + kk) * D + ch];
    const bf16* proj = WSP(bf16, WS_PROJ); bf16* ymix = WSP(bf16, WS_YMIX);
    float carry = 0.f;
    const int nch = SAMPLE ? 1 : 17;
#pragma unroll 1
    for (int ci = 0; ci < nch; ++ci) {
#pragma unroll 2
        for (int j = 0; j < 16; ++j) { const int t = 16 * w + j; float acc = cb;
            if (SAMPLE) { const int row = ROW_S + 128 * sq + t, bb = 32 * sq + (t >> 2), s = t & 3;
#pragma unroll
                for (int kk = 0; kk < 4; ++kk) { const int pos = s - 3 + kk;
                    const float v = pos >= 0 ? bf2f(proj[(size_t)(row - s + pos) * NIN + PXR + ch]) : P.in[I_LRUCONV][((size_t)(l * NSB + bb) * 3 + (3 + pos)) * D + ch];
                    acc += cwk[kk] * v; } }
            else { const int tt = ci == 0 ? t : NMETA + 128 * (ci - 1) + t; const bool valid = ci > 0 || t < NMETA;
#pragma unroll
                for (int kk = 0; kk < 4; ++kk) { const int tp = tt - 3 + kk;
                    const float v = (valid && tp >= 0) ? bf2f(proj[(size_t)prow(sq, tp) * NIN + PXR + ch]) : 0.f;
                    acc += cwk[kk] * v; } }
            XC[t * 64 + c] = acc; }
        __syncthreads();
        float Ap = 1.f, hl = 0.f;
        { float wv[64]; const float* pa2 = pa; const float* px2 = px; asm volatile("" : "+v"(pa2), "+v"(px2));
#pragma unroll
          for (int i = 0; i < 64; ++i) wv[i] = pa2[i * 64];
#pragma unroll 2
          for (int j = 0; j < 16; ++j) { const int t = 16 * w + j; float rp = ba;
#pragma unroll
              for (int i = 0; i < 64; i += 4) { const f32x4 xv = *(const LAS f32x4*)(XC + t * 64 + i); rp += (xv.x * wv[i] + xv.y * wv[i + 1]) + (xv.z * wv[i + 2] + xv.w * wv[i + 3]); }
              AV[t * 64 + c] = -8.0f * sigmoid_f(rp) * spl; }
          asm volatile("" ::: "memory");
#pragma unroll
          for (int i = 0; i < 64; ++i) wv[i] = px2[i * 64];
#pragma unroll 2
          for (int j = 0; j < 16; ++j) { const int t = 16 * w + j; float ip = bx;
#pragma unroll
              for (int i = 0; i < 64; i += 4) { const f32x4 xv = *(const LAS f32x4*)(XC + t * 64 + i); ip += (xv.x * wv[i] + xv.y * wv[i + 1]) + (xv.z * wv[i + 2] + xv.w * wv[i + 3]); }
              const float la = AV[t * 64 + c]; float a = __expf(la); float bt = sqrtf(-expm1f(2.0f * la)) * sigmoid_f(ip) * XC[t * 64 + c];
              if (SAMPLE) { const int bb = 32 * sq + (t >> 2); if ((t & 3) == 0) { bt += a * P.in[I_LRU][(size_t)(l * NSB + bb) * D + ch]; a = 0.f; } }
              else { if (ci == 0 && t >= NMETA) { a = 1.f; bt = 0.f; } }
              AV[t * 64 + c] = a; BV[t * 64 + c] = bt; hl = a * hl + bt; Ap *= a; } }
        SA[w * 64 + c] = Ap; SB[w * 64 + c] = hl;
        __syncthreads();
        float hin = carry, tot = carry;
#pragma unroll
        for (int w2 = 0; w2 < 8; ++w2) { const float A2 = SA[w2 * 64 + c], B2 = SB[w2 * 64 + c]; tot = A2 * tot + B2; if (w2 < w) hin = A2 * hin + B2; }
        float hc = hin;
#pragma unroll 2
        for (int j = 0; j < 16; ++j) { const int t = 16 * w + j; hc = AV[t * 64 + c] * hc + BV[t * 64 + c];
            int row; bool wr_;
            if (SAMPLE) { row = ROW_S + 128 * sq + t; wr_ = true; if ((t & 3) == 3) P.out[O_LRUS + (size_t)(l * NSB + 32 * sq + (t >> 2)) * D + ch] = hc; }
            else { const int tt = ci == 0 ? t : NMETA + 128 * (ci - 1) + t; row = prow(sq, tt); wr_ = ci > 0 || (t < NMETA && sq == 0); }
            if (wr_) { const float gt = bf2f(proj[(size_t)row * NIN + PGATE + ch]); ymix[(size_t)row * DMIX + D + ch] = (bf16)f2bf(hc * gelu_tanh_f(gt)); } }
        carry = tot;
        __syncthreads();
    }
    if (!SAMPLE && w == 0) P.out[O_LRUP + (size_t)(l * NPB + sq) * D + ch] = carry;
}

__device__ __forceinline__ void mixer_phase(const Params& P, const Ctx& C, int l) {
    const int bx = blockIdx.x;
#if SSD_NAIVE
    if (bx < 128) ssd_prompt_naive(P, C, l, bx >> 4, bx & 15);
#else
    if (bx < 128) ssd_prompt_mfma(P, C, l, bx >> 4, bx & 15);
#endif
    else if (bx < 256) lru_item<false>(P, C, l, (bx - 128) >> 4, (bx - 128) & 15);
    if (bx < 64) lru_item<true>(P, C, l, bx >> 4, bx & 15);
    for (int it = bx; it < NSB * 16 / 2; it += 256) { const int id = it * 2 + (C.tid >> 8); ssd_sample_item(P, C, l, id >> 4, id & 15); }
}

__device__ __forceinline__ void ynorm_phase(const Params& P, const Ctx& C, int l) {
    const float* ssq = (WSP(float, WS_CTL) + CW_SSQ) + (size_t)l * MP;
    for (int r = C.gw; r < NROWS; r += C.NGW) {
        const float rs = rsqrtf(ssq[r] * (1.f / D) + EPS);
        v4u* p = (v4u*)(WSP(bf16, WS_YMIX) + (size_t)r * DMIX) + 2 * C.lane;
#pragma unroll
        for (int i = 0; i < 2; ++i) { v4u w = p[i];
            w.x = pk2(bflo(w.x) * rs, bfhi(w.x) * rs); w.y = pk2(bflo(w.y) * rs, bfhi(w.y) * rs); w.z = pk2(bflo(w.z) * rs, bfhi(w.z) * rs); w.w = pk2(bflo(w.w) * rs, bfhi(w.w) * rs);
            p[i] = w; }
    }
}

constexpr int NPHASE = 1 + 12 * DEPTH;
__global__ void __launch_bounds__(NTHR, 2) hymba_fwd(Params P) {
    extern __shared__ __attribute__((aligned(16))) unsigned char lds_raw[];
    Ctx C;
    C.lds = (LAS unsigned char*)lds_raw;
    C.tid = threadIdx.x; C.lane = C.tid & 63; C.wave = __builtin_amdgcn_readfirstlane(C.tid >> 6);
    C.G = gridDim.x; C.gw = blockIdx.x * NWAVES + C.wave; C.NGW = C.G * NWAVES;
    unsigned char* ws = P.ws;
    volatile LAS unsigned* MISC = (volatile LAS unsigned*)(C.lds + MISC_OFF);
    for (int u = C.tid; u < 32; u += NTHR) ((LAS unsigned*)(C.lds + MISC_OFF))[u] = 0u;
    __syncthreads();
#if MEGA
    XcdBarrier bar = xcd_barrier_post((unsigned*)(ws + WS_CTL) + CW_BAR, MISC + 8);
#endif
    const int lo = P.ph_lo, hi = P.ph_hi;
#define IN(k) (lo <= (k) && (k) < hi)
#if MEGA
#define SEAM(k) do { if (IN(k) && IN((k) + 1)) xcd_barrier(bar); } while (0)
#else
#define SEAM(k) do { } while (0)
#endif
#define GEMM_PHASE(Aop, Btop, Nn, Kk, kind, perm, outp, ldo) do { pg8::Gemm g{Aop, Btop, MP, Nn, Kk}; pg8::StaticOrder S; S.init(MP, Nn, C.G, (int)blockIdx.x); \
        pg8::EpiAny E{kind, perm, outp, ldo}; pg8::gemm_phase<pg8::EpiAny, pg8::StaticOrder, true, true>(C.lds, g, S, E); } while (0)
    if (IN(0)) p0_prologue(P, C);
#if MEGA
    if (IN(0) && IN(1)) { VM_WAIT(); __syncthreads(); cg::this_grid().sync(); }
#endif
#define LAYER(l) do { constexpr int b0 = 1 + 12 * (l); \
    if (IN(b0 + 0)) GEMM_PHASE(WSP(bf16, WS_XB), WSP(bf16, WS_WGU1) + (size_t)(l) * NGU * D, NGU, D, 2, false, WSP(bf16, WS_H), DFF); SEAM(b0 + 0); \
    if (IN(b0 + 1)) GEMM_PHASE(WSP(bf16, WS_H), WSP(bf16, WS_WD1) + (size_t)(l) * D * DFF, D, DFF, 0, false, WSP(float, WS_Y), D); SEAM(b0 + 1); \
    if (IN(b0 + 2)) rn_phase(P, C, 0.5f, P.in[I_F1POST] + (l) * D, true, (l), false); SEAM(b0 + 2); \
    if (IN(b0 + 3)) GEMM_PHASE(WSP(bf16, WS_XB), WSP(bf16, WS_WIN) + (size_t)(l) * NIN * D, NIN, D, 1, true, WSP(bf16, WS_PROJ), NIN); SEAM(b0 + 3); \
    if (IN(b0 + 4)) conv_phase(P, C, (l)); SEAM(b0 + 4); \
    if (IN(b0 + 5)) mixer_phase(P, C, (l)); SEAM(b0 + 5); \
    if (IN(b0 + 6)) ynorm_phase(P, C, (l)); SEAM(b0 + 6); \
    if (IN(b0 + 7)) GEMM_PHASE(WSP(bf16, WS_YMIX), WSP(bf16, WS_WOUT) + (size_t)(l) * D * DMIX, D, DMIX, 0, false, WSP(float, WS_Y), D); SEAM(b0 + 7); \
    if (IN(b0 + 8)) rn_phase(P, C, 1.0f, P.in[I_MPOST] + (l) * D, false, (l), false); SEAM(b0 + 8); \
    if (IN(b0 + 9)) GEMM_PHASE(WSP(bf16, WS_XB), WSP(bf16, WS_WGU2) + (size_t)(l) * NGU * D, NGU, D, 2, false, WSP(bf16, WS_H), DFF); SEAM(b0 + 9); \
    if (IN(b0 + 10)) GEMM_PHASE(WSP(bf16, WS_H), WSP(bf16, WS_WD2) + (size_t)(l) * D * DFF, D, DFF, 0, false, WSP(float, WS_Y), D); SEAM(b0 + 10); \
    if (IN(b0 + 11)) rn_phase(P, C, 0.5f, P.in[I_F2POST] + (l) * D, false, (l), (l) == DEPTH - 1); SEAM(b0 + 11); } while (0)
    LAYER(0);
    LAYER(1);
}

extern "C" void kernel_launch(void* const* d_in, const int* in_sizes, int n_in, void* d_out, int out_size, void* d_ws, size_t ws_size, hipStream_t stream) {
    static int grid = 0;
    if (grid == 0) {
        if (n_in != N_IN || out_size != (int)O_END || ws_size < WS_END) { fprintf(stderr, "kernel_launch: built for %d inputs, %zu outputs, >= %zu bytes of workspace; got n_in %d, out %d, ws %zu; nothing launched\n", (int)N_IN, (size_t)O_END, (size_t)WS_END, n_in, out_size, ws_size); grid = -1; return; }
        int dev = 0, cus = 0, per_cu = 0;
        if (hipGetDevice(&dev) != hipSuccess || hipDeviceGetAttribute(&cus, hipDeviceAttributeMultiprocessorCount, dev) != hipSuccess) { fprintf(stderr, "kernel_launch: device query failed\n"); grid = -1; return; }
        if (hipFuncSetAttribute((const void*)hymba_fwd, hipFuncAttributeMaxDynamicSharedMemorySize, LDS_BYTES) != hipSuccess) { fprintf(stderr, "kernel_launch: hipFuncSetAttribute failed\n"); grid = -1; return; }
        if (hipOccupancyMaxActiveBlocksPerMultiprocessor(&per_cu, (const void*)hymba_fwd, NTHR, LDS_BYTES) != hipSuccess || per_cu < 1) { fprintf(stderr, "kernel_launch: occupancy query says %d blocks per CU\n", per_cu); grid = -1; return; }
        (void)hipGetLastError();
        grid = cus * per_cu; if (grid > 256) grid = 256;
        if (grid != 256) { fprintf(stderr, "kernel_launch: this kernel needs a 256-workgroup resident grid (got %d CUs x %d)\n", cus, per_cu); grid = -1; return; }
    }
    if (grid < 0) return;
    if (hipMemsetAsync((char*)d_ws + WS_CTL, 0, CTL_ZERO_BYTES, stream) != hipSuccess) { fprintf(stderr, "kernel_launch: hipMemsetAsync failed\n"); return; }
    Params a{};
    for (int i = 0; i < N_IN; ++i) a.in[i] = (const float*)d_in[i];
    a.out = (float*)d_out; a.ws = (unsigned char*)d_ws;
#if MEGA
    a.ph_lo = 0; a.ph_hi = NPHASE;
    void* args[] = {&a};
    hipError_t e = hipLaunchCooperativeKernel((const void*)hymba_fwd, dim3(grid), dim3(NTHR), args, LDS_BYTES, stream);
    if (e != hipSuccess) fprintf(stderr, "kernel_launch: cooperative launch failed: %s (grid %d)\n", hipGetErrorString(e), grid);
#else
    for (int ph = 0; ph < NPHASE; ++ph) { a.ph_lo = ph; a.ph_hi = ph + 1; hipLaunchKernelGGL(hymba_fwd, dim3(grid), dim3(NTHR), LDS_BYTES, stream, a); }
#endif
}
```

```cpp
#include <hip/hip_runtime.h>
#include <hip/hip_cooperative_groups.h>
#include <cstdio>
#include <cstdint>
namespace cg = cooperative_groups;

#ifndef SSD_NAIVE
#define SSD_NAIVE 0
#endif
#ifndef MEGA
#define MEGA 1
#endif

constexpr int D = 1024, DFF = 2816, NGU = 2 * DFF, NIN = 4608, DMIX = 2048, XBCW = 1536, INCOLS = 4624, DEPTH = 2;
constexpr int NPB = 8, SEQ = 2048, NSB = 128, NMETA = 16;
constexpr int ROW_S = 16384, ROW_M = 16896, NROWS = 16912, MP = 17152;
constexpr int PZ = 0, PX = 1024, PB = 2048, PC = 2304, PGATE = 2560, PXR = 3584;
constexpr float EPS = 1e-6f;
constexpr size_t O_YP = 0, O_YS = 16777216, O_SSDP = 17301504, O_CONVP = 19398656, O_LRUP = 19472384, O_LCONVP = 19488768, O_SSDS = 19537920, O_CONVS = 53092352, O_LRUS = 54272000, O_LCONVS = 54534144, O_END = 55320576;
enum { I_XP = 0, I_XS, I_SSD, I_SSDCONV, I_LRU, I_LRUCONV, I_META, I_F1PRE, I_F1POST, I_F1WG, I_F1WU, I_F1WD, I_MPRE, I_MPOST, I_WIN, I_CONVW, I_CONVB, I_DTB, I_ALOG, I_SSDD, I_SSDG,
       I_LCONVW, I_LCONVB, I_LWA, I_LBA, I_LWX, I_LBX, I_LLAM, I_WOUT, I_F2PRE, I_F2POST, I_F2WG, I_F2WU, I_F2WD, N_IN };
constexpr size_t MiB = 1u << 20;
constexpr size_t WS_CTL = 0, CTL_ZERO_BYTES = 1 * MiB;
constexpr size_t WS_WGU1 = 2 * MiB, WS_WD1 = 24 * MiB, WS_WIN = 35 * MiB, WS_WOUT = 53 * MiB, WS_WGU2 = 61 * MiB, WS_WD2 = 83 * MiB, WS_WDT = 94 * MiB;
constexpr size_t SZ_WGU = (size_t)NGU * D * 2, SZ_WD = (size_t)D * DFF * 2, SZ_WIN = (size_t)NIN * D * 2, SZ_WOUT = (size_t)D * DMIX * 2, SZ_WDT = 16 * D * 4;
constexpr size_t WS_XB = 95 * MiB, WS_X = 129 * MiB, WS_Y = 196 * MiB, WS_H = 263 * MiB, WS_PROJ = 356 * MiB, WS_XBCC = 507 * MiB, WS_DT = 558 * MiB, WS_YMIX = 560 * MiB, WS_END = 627 * MiB;
static_assert(WS_WGU1 + 2 * SZ_WGU <= WS_WD1 && WS_WD1 + 2 * SZ_WD <= WS_WIN && WS_WIN + 2 * SZ_WIN <= WS_WOUT && WS_WOUT + 2 * SZ_WOUT <= WS_WGU2 && WS_WGU2 + 2 * SZ_WGU <= WS_WD2 && WS_WD2 + 2 * SZ_WD <= WS_WDT && WS_WDT + 2 * SZ_WDT <= WS_XB, "weights map");
static_assert(WS_XB + (size_t)MP * D * 2 <= WS_X && WS_X + (size_t)MP * D * 4 <= WS_Y && WS_Y + (size_t)MP * D * 4 <= WS_H && WS_H + (size_t)MP * DFF * 2 <= WS_PROJ && WS_PROJ + (size_t)MP * NIN * 2 <= WS_XBCC &&
              WS_XBCC + (size_t)MP * XBCW * 2 <= WS_DT && WS_DT + (size_t)MP * 16 * 4 <= WS_YMIX && WS_YMIX + (size_t)MP * DMIX * 2 <= WS_END, "activation map");
constexpr int CW_BAR = 4096, CW_SSQ = 65536;
static_assert((size_t)(CW_SSQ + 2 * MP) * 4 <= CTL_ZERO_BYTES, "ctl map");
constexpr int RING_BYTES = 131072, LDS_BYTES = 163840, MISC_OFF = LDS_BYTES - 128;
constexpr int NWAVES = 8, NTHR = 512;
namespace pg8 {
#define PG8_LAS __attribute__((address_space(3)))
typedef unsigned short bf16_t;
typedef short bf16x8 __attribute__((ext_vector_type(8)));
typedef float f32x4 __attribute__((ext_vector_type(4)));
typedef unsigned u32x4 __attribute__((ext_vector_type(4)));
constexpr int BM = 256, BK = 64, HALF = 128, HTB = HALF * BK * 2  , STAGE_BYTES = 8 * HTB, NXCD = 8, WGM = 8;

__host__ __device__ __forceinline__ int lds_byte(int r, int c) { const int st = (r >> 4) * 2 + (c >> 5), rr = r & 15, cc = c & 31, ob = rr * 64 + cc * 2; return st * 1024 + (ob ^ (((ob >> 9) & 1) << 5)); }
__host__ __device__ __forceinline__ void stage_rc(int b, int& R, int& C) { const int st = b / 1024, sb = b % 1024, swz = sb ^ (((sb >> 9) & 1) << 5); R = (st >> 1) * 16 + swz / 64; C = (st & 1) * 32 + (swz % 64) / 2; }
__host__ __device__ __forceinline__ int perm32(int rho) { const int n = rho >> 4, i = rho & 15; return 8 * (i >> 2) + 4 * n + (i & 3); }

struct Unit { int pm, pn; };
struct Gemm { const bf16_t* A; const bf16_t* Bt; int M, N, K; };

struct StaticOrder {
    int nM, nN, nwg, G, c;
    __host__ __device__ void init(int M, int N, int G_, int c_) { nM = M / BM; nN = N / BM; nwg = nM * nN; G = G_; c = c_; }
    __host__ __device__ bool next(int i, Unit& u) const {
        const long L = (long)i * G + c; if (L >= nwg) return false;
        int wgid = (int)L; { const int q = nwg / NXCD, r = nwg % NXCD, xcd = wgid % NXCD, off = wgid / NXCD; wgid = (xcd < r ? xcd * (q + 1) : r * (q + 1) + (xcd - r) * q) + off; }
        const int nig = WGM * nN, gid = wgid / nig, fm = gid * WGM, gsz = (nM - fm) < WGM ? (nM - fm) : WGM;
        u.pm = fm + ((wgid % nig) % gsz); u.pn = (wgid % nig) / gsz; return true;
    }
    __device__ __forceinline__ void a_ready(const Unit&) const {}
    __device__ __forceinline__ void done(const Unit&) const {}
};
__device__ __forceinline__ unsigned cvt_pk_bf16(float lo, float hi) { unsigned r; asm volatile("v_cvt_pk_bf16_f32 %0, %1, %2" : "=v"(r) : "v"(lo), "v"(hi)); return r; }
typedef unsigned u32x2 __attribute__((ext_vector_type(2)));
struct EpiF32 {
    static constexpr bool PERM = false, AFTER_DRAIN = false;
    float* C; int ldc;
    __device__ __forceinline__ void operator()(const f32x4 (&acc)[2][2][4][2], const Unit& u, int wr, int wc, int fr, int fq) const {
        const int row0 = u.pm * BM + wr * 64 + fr, col0 = u.pn * BM + wc * 32 + 4 * fq;
#pragma unroll
        for (int ai = 0; ai < 2; ++ai)
#pragma unroll
            for (int m = 0; m < 4; ++m) { float* rowp = C + (size_t)(row0 + ai * HALF + m * 16) * ldc + col0;
#pragma unroll
                for (int bj = 0; bj < 2; ++bj)
#pragma unroll
                    for (int n = 0; n < 2; ++n) *(f32x4*)(rowp + bj * HALF + n * 16) = acc[ai][bj][m][n]; }
    }
};
struct EpiBf16P {
    static constexpr bool PERM = true, AFTER_DRAIN = false;
    bf16_t* O; int ldc;
    __device__ __forceinline__ void operator()(const f32x4 (&acc)[2][2][4][2], const Unit& u, int wr, int wc, int fr, int fq) const {
        const int row0 = u.pm * BM + wr * 64 + fr, col0 = u.pn * BM + wc * 32 + 8 * fq;
#pragma unroll
        for (int ai = 0; ai < 2; ++ai)
#pragma unroll
            for (int m = 0; m < 4; ++m) { bf16_t* rowp = O + (size_t)(row0 + ai * HALF + m * 16) * ldc + col0;
#pragma unroll
                for (int bj = 0; bj < 2; ++bj) { const f32x4 v0 = acc[ai][bj][m][0], v1 = acc[ai][bj][m][1];
                    u32x4 w; w.x = cvt_pk_bf16(v0[0], v0[1]); w.y = cvt_pk_bf16(v0[2], v0[3]); w.z = cvt_pk_bf16(v1[0], v1[1]); w.w = cvt_pk_bf16(v1[2], v1[3]);
                    *(u32x4*)(rowp + bj * HALF) = w; } }
    }
};
struct EpiSwiGLU {
    static constexpr bool PERM = false, AFTER_DRAIN = false;
    bf16_t* Hb; int ldh;
    __device__ __forceinline__ void operator()(const f32x4 (&acc)[2][2][4][2], const Unit& u, int wr, int wc, int fr, int fq) const {
        const int row0 = u.pm * BM + wr * 64 + fr;
#pragma unroll
        for (int ai = 0; ai < 2; ++ai)
#pragma unroll
            for (int m = 0; m < 4; ++m) { bf16_t* rowp = Hb + (size_t)(row0 + ai * HALF + m * 16) * ldh;
#pragma unroll
                for (int bj = 0; bj < 2; ++bj) { const int grp = u.pn * 8 + bj * 4 + wc; const f32x4 g = acc[ai][bj][m][0], up = acc[ai][bj][m][1]; float h[4];
#pragma unroll
                    for (int j = 0; j < 4; ++j) h[j] = g[j] * __builtin_amdgcn_rcpf(1.0f + __expf(-g[j])) * up[j];
                    u32x2 w; w.x = cvt_pk_bf16(h[0], h[1]); w.y = cvt_pk_bf16(h[2], h[3]);
                    *(u32x2*)(rowp + grp * 16 + 4 * fq) = w; } }
    }
};

struct EpiAny {
    static constexpr bool AFTER_DRAIN = false;
    int kind; bool perm; void* out; int ld;
    __device__ __forceinline__ void operator()(const f32x4 (&acc)[2][2][4][2], const Unit& u, int wr, int wc, int fr, int fq) const {
        if (kind == 0) { EpiF32 e{(float*)out, ld}; e(acc, u, wr, wc, fr, fq); }
        else if (kind == 1) { EpiBf16P e{(bf16_t*)out, ld}; e(acc, u, wr, wc, fr, fq); }
        else { EpiSwiGLU e{(bf16_t*)out, ld}; e(acc, u, wr, wc, fr, fq); }
    }
};
template <class Epi, class Sched, bool ALIGN_EPI = false, bool SP2 = false>
__device__ __forceinline__ void gemm_phase(PG8_LAS unsigned char* lds, const Gemm g, const Sched& S, const Epi& E) {
    const int tid = threadIdx.x, wid = __builtin_amdgcn_readfirstlane(tid >> 6), lane = tid & 63, wr = wid >> 2, wc = wid & 3, fr = lane & 15, fq = lane >> 4;
    const int K = g.K, nt = K / BK;
    unsigned voffA[2], voffB[2];
#pragma unroll
    for (int i = 0; i < 2; ++i) { int R, C; stage_rc(tid * 16 + i * 8192, R, C); const int Rb = E.perm ? ((R & ~31) + perm32(R & 31)) : R;
        voffA[i] = (unsigned)(R * K + C) * 2u; voffB[i] = (unsigned)(Rb * K + C) * 2u; }
    const size_t kstep = (size_t)(BK * 2);
    const size_t hstep = (size_t)HALF * K * 2;
    const size_t tstep = 2 * hstep;
    const unsigned ldsw = (unsigned)wid * 1024u;
    const int aoff = lds_byte(wr * 64 + fr, fq * 8), boff = lds_byte(wc * 32 + fr, fq * 8);
#define PG8_SA(b, h) (((b) * 2 + (h)) * HTB)
#define PG8_SB(b, h) ((4 + (b) * 2 + (h)) * HTB)
#define PG8_STAGE(bufoff, gbase, voff) do { _Pragma("unroll") for (int _i = 0; _i < 2; ++_i) \
        __builtin_amdgcn_global_load_lds((const unsigned*)((const char*)(gbase) + (voff)[_i]), (PG8_LAS unsigned*)(lds + (bufoff) + ldsw + _i * 8192), 16, 0, 0); } while (0)
#define PG8_LDA(dst, b, h) do { _Pragma("unroll") for (int m = 0; m < 4; ++m) _Pragma("unroll") for (int k = 0; k < 2; ++k) dst[m][k] = *(const PG8_LAS bf16x8*)(lds + PG8_SA(b, h) + aoff + m * 2048 + k * 1024); } while (0)
#define PG8_LDB(dst, b, h) do { _Pragma("unroll") for (int n = 0; n < 2; ++n) _Pragma("unroll") for (int k = 0; k < 2; ++k) dst[n][k] = *(const PG8_LAS bf16x8*)(lds + PG8_SB(b, h) + boff + n * 2048 + k * 1024); } while (0)
#define PG8_MMA(ai, bj, At, Bt) do { __builtin_amdgcn_s_setprio(1); _Pragma("unroll") for (int m = 0; m < 4; ++m) _Pragma("unroll") for (int n = 0; n < 2; ++n) _Pragma("unroll") for (int k = 0; k < 2; ++k) \
        acc[ai][bj][m][n] = __builtin_amdgcn_mfma_f32_16x16x32_bf16(Bt[n][k], At[m][k], acc[ai][bj][m][n], 0, 0, 0); __builtin_amdgcn_s_setprio(0); } while (0)
#define PG8_WAIT_V(n) asm volatile("s_waitcnt vmcnt(" #n ")" ::: "memory")
#define PG8_WAIT_L(n) asm volatile("s_waitcnt lgkmcnt(" #n ")" ::: "memory")
#define PG8_BAR __builtin_amdgcn_s_barrier()
#define PG8_SCHED __builtin_amdgcn_sched_barrier(0)
    Unit cur, nxt; int ui = 0;
    if (!S.next(0, cur)) return;
    f32x4 acc[2][2][4][2];
#pragma unroll
    for (int a = 0; a < 2; ++a)
#pragma unroll
        for (int b = 0; b < 2; ++b)
#pragma unroll
            for (int m = 0; m < 4; ++m)
#pragma unroll
                for (int n = 0; n < 2; ++n) acc[a][b][m][n] = (f32x4){0.f, 0.f, 0.f, 0.f};
    bf16x8 At[4][2], B0[2][2], B1[2][2];
    const char* cA = (const char*)g.A + (size_t)cur.pm * tstep; const char* cB = (const char*)g.Bt + (size_t)cur.pn * tstep;
    S.a_ready(cur);
    if constexpr (SP2) {
        PG8_STAGE(PG8_SB(0, 0), cB, voffB); PG8_STAGE(PG8_SB(0, 1), cB + hstep, voffB); PG8_STAGE(PG8_SA(0, 0), cA, voffA); PG8_STAGE(PG8_SA(0, 1), cA + hstep, voffA);
        if (wr == 1) PG8_BAR;
        PG8_WAIT_V(2); PG8_BAR;
        PG8_STAGE(PG8_SB(1, 0), cB + kstep, voffB); PG8_STAGE(PG8_SA(1, 0), cA + kstep, voffA); PG8_STAGE(PG8_SB(1, 1), cB + hstep + kstep, voffB);
        PG8_WAIT_V(6); PG8_BAR;
    } else {
        PG8_STAGE(PG8_SB(0, 0), cB, voffB); PG8_STAGE(PG8_SA(0, 0), cA, voffA); PG8_STAGE(PG8_SB(0, 1), cB + hstep, voffB); PG8_STAGE(PG8_SA(0, 1), cA + hstep, voffA);
        if (wr == 1) PG8_BAR;
        PG8_WAIT_V(4); PG8_BAR;
        PG8_STAGE(PG8_SB(1, 0), cB + kstep, voffB); PG8_STAGE(PG8_SA(1, 0), cA + kstep, voffA); PG8_STAGE(PG8_SB(1, 1), cB + hstep + kstep, voffB);
        PG8_WAIT_V(6); PG8_BAR;
    }
    for (;;) {
        const bool has_next = S.next(ui + 1, nxt);
        const char* nA = has_next ? (const char*)g.A + (size_t)nxt.pm * tstep : cA; const char* nB = has_next ? (const char*)g.Bt + (size_t)nxt.pn * tstep : cB;
        for (int t = 0; t < nt; t += 2) {
            const bool last = (t == nt - 2);
            const char* a1 = cA + (size_t)(t + 1) * kstep;
            const char* a2 = last ? nA : cA + (size_t)(t + 2) * kstep; const char* b2 = last ? nB : cB + (size_t)(t + 2) * kstep;
            const char* a3 = a2 + kstep; const char* b3 = b2 + kstep;
            if (last && has_next) S.a_ready(nxt);
            if constexpr (SP2) {
            PG8_LDB(B0, 0, 0); PG8_LDB(B1, 0, 1); PG8_SCHED; PG8_LDA(At, 0, 0); PG8_STAGE(PG8_SA(1, 1), a1 + hstep, voffA);
            PG8_WAIT_V(8); PG8_WAIT_L(0); PG8_BAR; PG8_MMA(0, 0, At, B0); PG8_MMA(0, 1, At, B1); PG8_BAR; PG8_SCHED;
            PG8_LDA(At, 0, 1); PG8_STAGE(PG8_SB(0, 0), b2, voffB); PG8_STAGE(PG8_SB(0, 1), b2 + hstep, voffB); PG8_STAGE(PG8_SA(0, 0), a2, voffA);
            PG8_WAIT_V(8); PG8_WAIT_L(0); PG8_BAR; PG8_MMA(1, 0, At, B0); PG8_MMA(1, 1, At, B1); PG8_BAR; PG8_SCHED;
            PG8_LDB(B0, 1, 0); PG8_LDB(B1, 1, 1); PG8_SCHED; PG8_LDA(At, 1, 0); PG8_STAGE(PG8_SA(0, 1), a2 + hstep, voffA);
            PG8_WAIT_V(8); PG8_WAIT_L(0); PG8_BAR; PG8_MMA(0, 0, At, B0); PG8_MMA(0, 1, At, B1); PG8_BAR; PG8_SCHED;
            PG8_LDA(At, 1, 1); PG8_STAGE(PG8_SB(1, 0), b3, voffB); PG8_STAGE(PG8_SB(1, 1), b3 + hstep, voffB); PG8_STAGE(PG8_SA(1, 0), a3, voffA);
            PG8_WAIT_V(8); PG8_WAIT_L(0); PG8_BAR; PG8_MMA(1, 0, At, B0); PG8_MMA(1, 1, At, B1); PG8_BAR; PG8_SCHED;
            } else {
            PG8_LDB(B0, 0, 0); PG8_SCHED; PG8_LDA(At, 0, 0); PG8_STAGE(PG8_SA(1, 1), a1 + hstep, voffA);
            PG8_WAIT_L(8); PG8_BAR; PG8_WAIT_L(0); PG8_MMA(0, 0, At, B0); PG8_BAR; PG8_SCHED;
            PG8_LDB(B1, 0, 1); PG8_STAGE(PG8_SB(0, 0), b2, voffB);
            PG8_BAR; PG8_WAIT_L(0); PG8_MMA(0, 1, At, B1); PG8_BAR;
            PG8_LDA(At, 0, 1); PG8_STAGE(PG8_SA(0, 0), a2, voffA);
            PG8_BAR; PG8_WAIT_L(0); PG8_MMA(1, 0, At, B0); PG8_BAR; PG8_SCHED;
            PG8_STAGE(PG8_SB(0, 1), b2 + hstep, voffB);
            PG8_WAIT_V(6); PG8_BAR; PG8_MMA(1, 1, At, B1); PG8_BAR;
            PG8_LDB(B0, 1, 0); PG8_SCHED; PG8_LDA(At, 1, 0); PG8_STAGE(PG8_SA(0, 1), a2 + hstep, voffA);
            PG8_WAIT_L(8); PG8_BAR; PG8_WAIT_L(0); PG8_MMA(0, 0, At, B0); PG8_BAR; PG8_SCHED;
            PG8_LDB(B1, 1, 1); PG8_STAGE(PG8_SB(1, 0), b3, voffB);
            PG8_BAR; PG8_WAIT_L(0); PG8_MMA(0, 1, At, B1); PG8_BAR;
            PG8_LDA(At, 1, 1); PG8_STAGE(PG8_SA(1, 0), a3, voffA);
            PG8_BAR; PG8_WAIT_L(0); PG8_MMA(1, 0, At, B0); PG8_BAR; PG8_SCHED;
            PG8_STAGE(PG8_SB(1, 1), b3 + hstep, voffB);
            PG8_WAIT_V(6); PG8_BAR; PG8_MMA(1, 1, At, B1); PG8_BAR;
            }
        }
        if constexpr (ALIGN_EPI) { if (wr == 0) PG8_BAR; }
        if constexpr (!Epi::AFTER_DRAIN) { E(acc, cur, wr, wc, fr, fq); S.done(cur); }
        if (!has_next) break;
#pragma unroll
        for (int a = 0; a < 2; ++a)
#pragma unroll
            for (int b = 0; b < 2; ++b)
#pragma unroll
                for (int m = 0; m < 4; ++m)
#pragma unroll
                    for (int n = 0; n < 2; ++n) acc[a][b][m][n] = (f32x4){0.f, 0.f, 0.f, 0.f};
        cur = nxt; cA = nA; cB = nB; ++ui;
        if constexpr (ALIGN_EPI) { if (wr == 1) PG8_BAR; }
    }
    PG8_WAIT_V(0);
    if constexpr (!ALIGN_EPI) { if (wr == 0) PG8_BAR; }
    PG8_BAR;
    if constexpr (Epi::AFTER_DRAIN) { E.fused(acc, cur, wr, wc, fr, fq, lds, wid, lane); S.done(cur); }
#undef PG8_SA
#undef PG8_SB
#undef PG8_STAGE
#undef PG8_LDA
#undef PG8_LDB
#undef PG8_MMA
#undef PG8_WAIT_V
#undef PG8_WAIT_L
#undef PG8_BAR
#undef PG8_SCHED
}
}

#define GAS __attribute__((address_space(1)))
#define LAS __attribute__((address_space(3)))
typedef unsigned short bf16;
typedef unsigned v4u __attribute__((ext_vector_type(4)));
typedef unsigned v2u __attribute__((ext_vector_type(2)));
typedef float f32x4 __attribute__((ext_vector_type(4)));
typedef GAS unsigned gu32;
#define LDS_WAIT() asm volatile("s_waitcnt lgkmcnt(0)" ::: "memory")
#define VM_WAIT() asm volatile("s_waitcnt vmcnt(0)" ::: "memory")
__device__ __forceinline__ unsigned f2bf(float f) { unsigned u = __builtin_bit_cast(unsigned, f); return (u + 0x7fffu + ((u >> 16) & 1u)) >> 16; }
__device__ __forceinline__ unsigned pk2(float lo, float hi) { return f2bf(lo) | (f2bf(hi) << 16); }
__device__ __forceinline__ float bf2f(unsigned short b) { return __builtin_bit_cast(float, (unsigned)b << 16); }
__device__ __forceinline__ float bflo(unsigned w) { return __builtin_bit_cast(float, w << 16); }
__device__ __forceinline__ float bfhi(unsigned w) { return __builtin_bit_cast(float, w & 0xffff0000u); }
__device__ __forceinline__ float wave_sum(float v) {
#pragma unroll
    for (int o = 1; o < 64; o <<= 1) v += __shfl_xor(v, o);
    return v;
}
__device__ __forceinline__ float silu_f(float x) { return x * __builtin_amdgcn_rcpf(1.0f + __expf(-x)); }
__device__ __forceinline__ float sigmoid_f(float x) { return __builtin_amdgcn_rcpf(1.0f + __expf(-x)); }
__device__ __forceinline__ float softplus_f(float z) { return z > 0.f ? z + log1pf(expf(-z)) : log1pf(expf(z)); }
__device__ __forceinline__ float gelu_tanh_f(float x) { const float u = 0.7978845608028654f * (x + 0.044715f * x * x * x); const float t = 1.0f - 2.0f * __builtin_amdgcn_rcpf(__expf(2.0f * u) + 1.0f); return 0.5f * x * (1.0f + t); }

#define XB_TMO      128
#define XB_XCNT(j)  (256  + 64 * (j))
#define XB_XSUB(j)  (1280 + 64 * (j))
#define XB_XGEN(j)  (2304 + 64 * (j))
#define XB_TOP      3328
#define XB_TOPGEN   3392
#define XCD_BAR_WORDS 3456
#define XB_SPIN_CAP (1u << 18)

__device__ __forceinline__ unsigned xb_ld(unsigned* p)              { return __hip_atomic_load(p, __ATOMIC_RELAXED, __HIP_MEMORY_SCOPE_AGENT); }
__device__ __forceinline__ unsigned xb_add(unsigned* p, unsigned v) { return __hip_atomic_fetch_add(p, v, __ATOMIC_RELAXED, __HIP_MEMORY_SCOPE_AGENT); }
__device__ __forceinline__ unsigned xb_xcc_id() { return (unsigned)__builtin_amdgcn_s_getreg((3 << 11) | 20) & 0xFu; }
#define XB_SPIN(cond, bar) do { unsigned _sp = 0; while (cond) { __builtin_amdgcn_s_sleep(1); \
    if ((++_sp & 255u) == 0u) { if (xb_ld(&(bar)[XB_TMO])) break; if (_sp > XB_SPIN_CAP) { atomicAdd(&(bar)[XB_TMO], 1u); break; } } } } while (0)

struct XcdBarrier {
    unsigned* bar; unsigned x;
    volatile LAS unsigned* st;
};

__device__ __forceinline__ XcdBarrier xcd_barrier_post(unsigned* bar, volatile LAS unsigned* st) {
    XcdBarrier b; b.bar = bar; b.x = xb_xcc_id(); b.st = st;
    if (threadIdx.x == 0) (void)xb_add(&bar[XB_XCNT(b.x)], 1u);
    return b;
}
__device__ __forceinline__ void xcd_barrier_complete(unsigned* bar, unsigned x, unsigned& nloc, unsigned& nx) {
    const unsigned G = gridDim.x * gridDim.y * gridDim.z;
    unsigned sum, cnt, mine, sp = 0u;
    for (;;) {
        sum = 0u; cnt = 0u; mine = 0u;
#pragma unroll
        for (unsigned j = 0; j < 16; ++j) { const unsigned c = xb_ld(&bar[XB_XCNT(j)]); sum += c; cnt += (c > 0u) ? 1u : 0u; mine = (j == x) ? c : mine; }
        if (sum == G) break;
        __builtin_amdgcn_s_sleep(1);
        if ((++sp & 255u) == 0u) { if (xb_ld(&bar[XB_TMO])) break; if (sp > XB_SPIN_CAP) { atomicAdd(&bar[XB_TMO], 1u); break; } }
    }
    nloc = mine > 0u ? mine : 1u; nx = cnt > 0u ? cnt : 1u;
}

__device__ __forceinline__ void xcd_barrier(const XcdBarrier& b) {
    asm volatile("s_waitcnt vmcnt(0)" ::: "memory");
    __syncthreads();
    if (threadIdx.x == 0) {
        unsigned* bar = b.bar;
        __builtin_amdgcn_s_waitcnt(0);
        unsigned nloc = b.st[0], nx = b.st[1];
        if (nloc == 0u) { xcd_barrier_complete(bar, b.x, nloc, nx); b.st[0] = nloc; b.st[1] = nx; }
        const unsigned old = xb_add(&bar[XB_XSUB(b.x)], 1u);
        const unsigned gen = old / nloc;
        if (old + 1u == (gen + 1u) * nloc) {
            __builtin_amdgcn_fence(__ATOMIC_RELEASE, "agent");
            asm volatile("s_waitcnt vmcnt(0)" ::: "memory");
            const unsigned og = xb_add(&bar[XB_TOP], 1u);
            const unsigned tg = og / nx;
            if (og + 1u == (tg + 1u) * nx) xb_add(&bar[XB_TOPGEN], 1u);
            else XB_SPIN(xb_ld(&bar[XB_TOPGEN]) == tg, bar);
            __builtin_amdgcn_fence(__ATOMIC_ACQUIRE, "agent");
            xb_add(&bar[XB_XGEN(b.x)], 1u);
            asm volatile("s_waitcnt vmcnt(0)" ::: "memory");
        } else {
            XB_SPIN(xb_ld(&bar[XB_XGEN(b.x)]) == gen, bar);
            __builtin_amdgcn_fence(__ATOMIC_ACQUIRE, "agent");
            asm volatile("s_waitcnt vmcnt(0)" ::: "memory");
        }
    }
    __syncthreads();
}

struct Params { const float* in[N_IN]; float* out; unsigned char* ws; int ph_lo, ph_hi; };
#define WSP(T, off) ((T*)(P.ws + (off)))
struct Ctx {
    LAS unsigned char* lds; int tid, lane, wave, G, gw, NGW, sslot;
};
__device__ __forceinline__ int prow(int b, int tt) { return tt < NMETA ? ROW_M + tt : b * SEQ + tt - NMETA; }

template <int MODE> __device__ __forceinline__ int dest_row(int n) {
    if (MODE == 1) return (n >> 4) * 32 + (n & 15);
    if (MODE == 2) return (n >> 4) * 32 + 16 + (n & 15);
    if (MODE == 3) return n < 2560 ? n : (n < 2576 ? -1 : n - 16);
    return n;
}
template <int MODE> __device__ __forceinline__ void transpose_item(const float* W, int K, int N, const float* gk, int gsplit, bf16* WT, LAS float* scr, int item, int lane) {
    const int nblk = (N + 31) / 32, kb = item / nblk, nb = item % nblk, k0 = 64 * kb, n0 = 32 * nb;
    const int col = n0 + (lane & 31);
#pragma unroll 8
    for (int i = 0; i < 32; ++i) { const int kk = 2 * i + (lane >> 5); const int k = k0 + kk;
        float v = col < N ? W[(size_t)k * N + col] : 0.f; if (gk != nullptr && k < gsplit) v *= gk[k];
        scr[kk * 33 + (lane & 31)] = v; }
    LDS_WAIT(); asm volatile("" ::: "memory");
    const int c = lane & 7;
#pragma unroll
    for (int j = 0; j < 4; ++j) { const int n = (lane >> 3) + 8 * j; const LAS float* s = scr + (8 * c) * 33 + n; const int dr = dest_row<MODE>(n0 + n);
        if (n0 + n < N && dr >= 0) { v4u o; o.x = pk2(s[0 * 33], s[1 * 33]); o.y = pk2(s[2 * 33], s[3 * 33]); o.z = pk2(s[4 * 33], s[5 * 33]); o.w = pk2(s[6 * 33], s[7 * 33]);
            *(v4u*)(WT + (size_t)dr * K + k0 + 8 * c) = o; } }
    LDS_WAIT(); asm volatile("" ::: "memory");
}
__device__ __forceinline__ void p0_prologue(const Params& P, const Ctx& C) {
    LAS float* scr = (LAS float*)(C.lds + C.wave * 16384);
    constexpr int I_GU = (D / 64) * (DFF / 32), I_D = (DFF / 64) * (D / 32), I_IN = (D / 64) * ((INCOLS + 31) / 32), I_OUT = (DMIX / 64) * (D / 32);
    constexpr int PER_L = 4 * I_GU + 2 * I_D + I_IN + I_OUT;
    for (int it = C.gw; it < DEPTH * PER_L; it += C.NGW) {
        const int l = it / PER_L; int r = it % PER_L;
        if (r < I_GU) { transpose_item<1>(P.in[I_F1WG] + (size_t)l * D * DFF, D, DFF, P.in[I_F1PRE] + l * D, D, WSP(bf16, WS_WGU1) + (size_t)l * NGU * D, scr, r, C.lane); continue; } r -= I_GU;
        if (r < I_GU) { transpose_item<2>(P.in[I_F1WU] + (size_t)l * D * DFF, D, DFF, P.in[I_F1PRE] + l * D, D, WSP(bf16, WS_WGU1) + (size_t)l * NGU * D, scr, r, C.lane); continue; } r -= I_GU;
        if (r < I_GU) { transpose_item<1>(P.in[I_F2WG] + (size_t)l * D * DFF, D, DFF, P.in[I_F2PRE] + l * D, D, WSP(bf16, WS_WGU2) + (size_t)l * NGU * D, scr, r, C.lane); continue; } r -= I_GU;
        if (r < I_GU) { transpose_item<2>(P.in[I_F2WU] + (size_t)l * D * DFF, D, DFF, P.in[I_F2PRE] + l * D, D, WSP(bf16, WS_WGU2) + (size_t)l * NGU * D, scr, r, C.lane); continue; } r -= I_GU;
        if (r < I_D) { transpose_item<0>(P.in[I_F1WD] + (size_t)l * DFF * D, DFF, D, nullptr, 0, WSP(bf16, WS_WD1) + (size_t)l * D * DFF, scr, r, C.lane); continue; } r -= I_D;
        if (r < I_D) { transpose_item<0>(P.in[I_F2WD] + (size_t)l * DFF * D, DFF, D, nullptr, 0, WSP(bf16, WS_WD2) + (size_t)l * D * DFF, scr, r, C.lane); continue; } r -= I_D;
        if (r < I_IN) { transpose_item<3>(P.in[I_WIN] + (size_t)l * D * INCOLS, D, INCOLS, P.in[I_MPRE] + l * D, D, WSP(bf16, WS_WIN) + (size_t)l * NIN * D, scr, r, C.lane); continue; } r -= I_IN;
        transpose_item<0>(P.in[I_WOUT] + (size_t)l * DMIX * D, DMIX, D, P.in[I_SSDG] + l * D, D, WSP(bf16, WS_WOUT) + (size_t)l * D * DMIX, scr, r, C.lane);
    }
    for (int i = C.gw * 64 + C.lane; i < DEPTH * 16 * D; i += C.NGW * 64) { const int l = i / (16 * D), j = (i / D) % 16, k = i % D;
        WSP(float, WS_WDT)[i] = P.in[I_WIN][(size_t)l * D * INCOLS + (size_t)k * INCOLS + 2560 + j] * P.in[I_MPRE][l * D + k]; }
    for (int r = C.gw; r < MP; r += C.NGW) {
        const float* src = r < ROW_S ? P.in[I_XP] + (size_t)r * D : (r < ROW_M ? P.in[I_XS] + (size_t)(r - ROW_S) * D : (r < NROWS ? P.in[I_META] + (size_t)(r - ROW_M) * D : nullptr));
        f32x4 v[4]; float s = 0.f;
#pragma unroll
        for (int j = 0; j < 4; ++j) { v[j] = src ? ((const f32x4*)src)[C.lane + 64 * j] : (f32x4){0.f, 0.f, 0.f, 0.f}; s += (v[j].x * v[j].x + v[j].y * v[j].y) + (v[j].z * v[j].z + v[j].w * v[j].w); }
        const float rs = rsqrtf(wave_sum(s) * (1.f / D) + EPS);
#pragma unroll
        for (int j = 0; j < 4; ++j) { ((f32x4*)(WSP(float, WS_X) + (size_t)r * D))[C.lane + 64 * j] = v[j];
            v2u o; o.x = pk2(v[j].x * rs, v[j].y * rs); o.y = pk2(v[j].z * rs, v[j].w * rs); ((v2u*)(WSP(bf16, WS_XB) + (size_t)r * D))[C.lane + 64 * j] = o; }
    }
}

__device__ __forceinline__ void rn_phase(const Params& P, const Ctx& C, float cc, const float* gpost, bool do_dt, int l, bool fin) {
    LAS float* wl = (LAS float*)C.lds;
    if (do_dt) { for (int i = C.tid; i < 16 * D / 4; i += NTHR) ((LAS f32x4*)wl)[i] = ((const f32x4*)(WSP(float, WS_WDT) + (size_t)l * 16 * D))[i]; __syncthreads(); }
    for (int r = C.gw; r < NROWS; r += C.NGW) {
        f32x4 v[4]; float s = 0.f;
#pragma unroll
        for (int j = 0; j < 4; ++j) { v[j] = ((const f32x4*)(WSP(float, WS_Y) + (size_t)r * D))[C.lane + 64 * j]; s += (v[j].x * v[j].x + v[j].y * v[j].y) + (v[j].z * v[j].z + v[j].w * v[j].w); }
        const float rs = rsqrtf(wave_sum(s) * (1.f / D) + EPS) * cc; float s2 = 0.f;
#pragma unroll
        for (int j = 0; j < 4; ++j) { const f32x4 g = ((const f32x4*)gpost)[C.lane + 64 * j], x0 = ((const f32x4*)(WSP(float, WS_X) + (size_t)r * D))[C.lane + 64 * j];
            v[j] = x0 + v[j] * rs * g; s2 += (v[j].x * v[j].x + v[j].y * v[j].y) + (v[j].z * v[j].z + v[j].w * v[j].w); }
        const float rs2 = rsqrtf(wave_sum(s2) * (1.f / D) + EPS);
        if (fin) { if (r < ROW_M) {
#pragma unroll
            for (int j = 0; j < 4; ++j) ((f32x4*)(P.out + (size_t)r * D))[C.lane + 64 * j] = v[j]; } }
        else {
#pragma unroll
            for (int j = 0; j < 4; ++j) { ((f32x4*)(WSP(float, WS_X) + (size_t)r * D))[C.lane + 64 * j] = v[j];
                v2u o; o.x = pk2(v[j].x * rs2, v[j].y * rs2); o.y = pk2(v[j].z * rs2, v[j].w * rs2); ((v2u*)(WSP(bf16, WS_XB) + (size_t)r * D))[C.lane + 64 * j] = o; }
        }
        if (do_dt) { float mine = 0.f;
#pragma unroll 1
            for (int j16 = 0; j16 < 16; ++j16) { float a = 0.f;
#pragma unroll
                for (int j = 0; j < 4; ++j) { const f32x4 w = ((const LAS f32x4*)(wl + j16 * D))[C.lane + 64 * j]; a += (v[j].x * w.x + v[j].y * w.y) + (v[j].z * w.z + v[j].w * w.w); }
                a = wave_sum(a); if (C.lane == j16) mine = a; }
            if (C.lane < 16) WSP(float, WS_DT)[(size_t)r * 16 + C.lane] = softplus_f(mine * rs2 + P.in[I_DTB][l * 16 + C.lane]); }
    }
}

__device__ __forceinline__ void conv_phase(const Params& P, const Ctx& C, int l) {
    const size_t gt = (size_t)C.gw * 64 + C.lane, NT = (size_t)C.NGW * 64;
    const float* cw = P.in[I_CONVW] + (size_t)l * 4 * XBCW; const float* cb = P.in[I_CONVB] + (size_t)l * XBCW;
    for (size_t idx = gt; idx < (size_t)NROWS * (XBCW / 8); idx += NT) {
        const int r = (int)(idx / (XBCW / 8)), ch = (int)(idx % (XBCW / 8)) * 8;
        float acc[8];
        { const f32x4 b0 = *(const f32x4*)(cb + ch), b1 = *(const f32x4*)(cb + ch + 4); acc[0] = b0.x; acc[1] = b0.y; acc[2] = b0.z; acc[3] = b0.w; acc[4] = b1.x; acc[5] = b1.y; acc[6] = b1.z; acc[7] = b1.w; }
#pragma unroll
        for (int k = 0; k < 4; ++k) {
            int srow = -1; const float* fsrc = nullptr;
            if (r < ROW_S) { const int t = r & (SEQ - 1), tp = t - 3 + k; srow = tp >= 0 ? r - 3 + k : ROW_M + NMETA + tp; }
            else if (r < ROW_M) { const int q = r - ROW_S, b = q >> 2, s = q & 3, pos = s - 3 + k; if (pos >= 0) srow = ROW_S + 4 * b + pos; else fsrc = P.in[I_SSDCONV] + ((size_t)(l * NSB + b) * 3 + (3 + pos)) * XBCW + ch; }
            else { const int pos = (r - ROW_M) - 3 + k; if (pos >= 0) srow = ROW_M + pos; }
            float xv[8];
            if (srow >= 0) { const v4u w = *(const v4u*)(WSP(bf16, WS_PROJ) + (size_t)srow * NIN + PX + ch); xv[0] = bflo(w.x); xv[1] = bfhi(w.x); xv[2] = bflo(w.y); xv[3] = bfhi(w.y); xv[4] = bflo(w.z); xv[5] = bfhi(w.z); xv[6] = bflo(w.w); xv[7] = bfhi(w.w); }
            else if (fsrc) { const f32x4 a0 = *(const f32x4*)fsrc, a1 = *(const f32x4*)(fsrc + 4); xv[0] = a0.x; xv[1] = a0.y; xv[2] = a0.z; xv[3] = a0.w; xv[4] = a1.x; xv[5] = a1.y; xv[6] = a1.z; xv[7] = a1.w; }
            else {
#pragma unroll
                for (int e = 0; e < 8; ++e) xv[e] = 0.f; }
            const f32x4 w0 = *(const f32x4*)(cw + (size_t)k * XBCW + ch), w1 = *(const f32x4*)(cw + (size_t)k * XBCW + ch + 4);
            acc[0] += w0.x * xv[0]; acc[1] += w0.y * xv[1]; acc[2] += w0.z * xv[2]; acc[3] += w0.w * xv[3]; acc[4] += w1.x * xv[4]; acc[5] += w1.y * xv[5]; acc[6] += w1.z * xv[6]; acc[7] += w1.w * xv[7];
        }
        v4u o; o.x = pk2(silu_f(acc[0]), silu_f(acc[1])); o.y = pk2(silu_f(acc[2]), silu_f(acc[3])); o.z = pk2(silu_f(acc[4]), silu_f(acc[5])); o.w = pk2(silu_f(acc[6]), silu_f(acc[7]));
        *(v4u*)(WSP(bf16, WS_XBCC) + (size_t)r * XBCW + ch) = o;
    }
    for (size_t i = gt; i < (size_t)NPB * 3 * XBCW; i += NT) { const int b = (int)(i / (3 * XBCW)), j = (int)(i / XBCW) % 3, ch = (int)(i % XBCW);
        P.out[O_CONVP + (size_t)l * NPB * 3 * XBCW + i] = bf2f(WSP(bf16, WS_PROJ)[(size_t)(b * SEQ + SEQ - 3 + j) * NIN + PX + ch]); }
    for (size_t i = gt; i < (size_t)NPB * 3 * D; i += NT) { const int b = (int)(i / (3 * D)), j = (int)(i / D) % 3, ch = (int)(i % D);
        P.out[O_LCONVP + (size_t)l * NPB * 3 * D + i] = bf2f(WSP(bf16, WS_PROJ)[(size_t)(b * SEQ + SEQ - 3 + j) * NIN + PXR + ch]); }
    for (size_t i = gt; i < (size_t)NSB * 3 * XBCW; i += NT) { const int b = (int)(i / (3 * XBCW)), j = (int)(i / XBCW) % 3, ch = (int)(i % XBCW);
        P.out[O_CONVS + (size_t)l * NSB * 3 * XBCW + i] = bf2f(WSP(bf16, WS_PROJ)[(size_t)(ROW_S + 4 * b + 1 + j) * NIN + PX + ch]); }
    for (size_t i = gt; i < (size_t)NSB * 3 * D; i += NT) { const int b = (int)(i / (3 * D)), j = (int)(i / D) % 3, ch = (int)(i % D);
        P.out[O_LCONVS + (size_t)l * NSB * 3 * D + i] = bf2f(WSP(bf16, WS_PROJ)[(size_t)(ROW_S + 4 * b + 1 + j) * NIN + PXR + ch]); }
}

__device__ __forceinline__ void ssd_prompt_naive(const Params& P, const Ctx& C, int l, int b, int h) {
    const int tid = C.tid, p = tid >> 3, ng = tid & 7, g = h >> 3;
    LAS bf16* Bs = (LAS bf16*)C.lds; LAS bf16* Cs = (LAS bf16*)(C.lds + 16384); LAS bf16* Xs = (LAS bf16*)(C.lds + 32768);
    LAS float* dts = (LAS float*)(C.lds + 40960); LAS int* rws = (LAS int*)(C.lds + 41216); LAS float* yb = (LAS float*)(C.lds + 41472);
    float S[16];
#pragma unroll
    for (int i = 0; i < 16; ++i) S[i] = 0.f;
    const float a = -expf(P.in[I_ALOG][l * 16 + h]), Dh = P.in[I_SSDD][l * 16 + h];
    float* ssq = (WSP(float, WS_CTL) + CW_SSQ) + (size_t)(l + C.sslot) * MP;
    for (int c0 = 0; c0 < SEQ + NMETA; c0 += 64) {
        const int nv = (SEQ + NMETA - c0) < 64 ? (SEQ + NMETA - c0) : 64;
        { const int tl = tid >> 3, part = tid & 7;
          if (tl < nv) { const int row = prow(b, c0 + tl); const bf16* src = WSP(bf16, WS_XBCC) + (size_t)row * XBCW;
              *(LAS v4u*)(Bs + tl * 128 + part * 16) = *(const v4u*)(src + 1024 + g * 128 + part * 16); *(LAS v4u*)(Bs + tl * 128 + part * 16 + 8) = *(const v4u*)(src + 1024 + g * 128 + part * 16 + 8);
              *(LAS v4u*)(Cs + tl * 128 + part * 16) = *(const v4u*)(src + 1280 + g * 128 + part * 16); *(LAS v4u*)(Cs + tl * 128 + part * 16 + 8) = *(const v4u*)(src + 1280 + g * 128 + part * 16 + 8);
              *(LAS v4u*)(Xs + tl * 64 + part * 8) = *(const v4u*)(src + h * 64 + part * 8);
              if (part == 0) { dts[tl] = WSP(float, WS_DT)[(size_t)row * 16 + h]; rws[tl] = row; } } }
        __syncthreads();
        for (int tl = 0; tl < nv; ++tl) {
            const float dt = dts[tl], dA = __expf(dt * a), x = bf2f(Xs[tl * 64 + p]), dtx = dt * x;
            const v4u b0 = *(const LAS v4u*)(Bs + tl * 128 + ng * 16), b1 = *(const LAS v4u*)(Bs + tl * 128 + ng * 16 + 8), c0v = *(const LAS v4u*)(Cs + tl * 128 + ng * 16), c1v = *(const LAS v4u*)(Cs + tl * 128 + ng * 16 + 8);
            float acc = 0.f;
#pragma unroll
            for (int w = 0; w < 4; ++w) { const unsigned bw = b0[w], cwd = c0v[w];
                S[2 * w] = dA * S[2 * w] + dtx * bflo(bw); acc += S[2 * w] * bflo(cwd); S[2 * w + 1] = dA * S[2 * w + 1] + dtx * bfhi(bw); acc += S[2 * w + 1] * bfhi(cwd); }
#pragma unroll
            for (int w = 0; w < 4; ++w) { const unsigned bw = b1[w], cwd = c1v[w];
                S[8 + 2 * w] = dA * S[8 + 2 * w] + dtx * bflo(bw); acc += S[8 + 2 * w] * bflo(cwd); S[8 + 2 * w + 1] = dA * S[8 + 2 * w + 1] + dtx * bfhi(bw); acc += S[8 + 2 * w + 1] * bfhi(cwd); }
            acc += __shfl_xor(acc, 1); acc += __shfl_xor(acc, 2); acc += __shfl_xor(acc, 4);
            if (ng == 0) yb[tl * 64 + p] = acc + Dh * x;
        }
        __syncthreads();
        { const int tl = tid >> 3, pp = (tid & 7) * 8; float sq = 0.f; int row = 0;
          const bool act = tl < nv && (b == 0 || c0 + tl >= NMETA);
          if (act) { row = rws[tl]; const v4u z = *(const v4u*)(WSP(bf16, WS_PROJ) + (size_t)row * NIN + PZ + h * 64 + pp); float y[8];
              y[0] = yb[tl * 64 + pp + 0] * silu_f(bflo(z.x)); y[1] = yb[tl * 64 + pp + 1] * silu_f(bfhi(z.x)); y[2] = yb[tl * 64 + pp + 2] * silu_f(bflo(z.y)); y[3] = yb[tl * 64 + pp + 3] * silu_f(bfhi(z.y));
              y[4] = yb[tl * 64 + pp + 4] * silu_f(bflo(z.z)); y[5] = yb[tl * 64 + pp + 5] * silu_f(bfhi(z.z)); y[6] = yb[tl * 64 + pp + 6] * silu_f(bflo(z.w)); y[7] = yb[tl * 64 + pp + 7] * silu_f(bfhi(z.w));
#pragma unroll
              for (int e = 0; e < 8; ++e) sq += y[e] * y[e];
              v4u o; o.x = pk2(y[0], y[1]); o.y = pk2(y[2], y[3]); o.z = pk2(y[4], y[5]); o.w = pk2(y[6], y[7]);
              *(v4u*)(WSP(bf16, WS_YMIX) + (size_t)row * DMIX + h * 64 + pp) = o; }
          sq += __shfl_xor(sq, 1); sq += __shfl_xor(sq, 2); sq += __shfl_xor(sq, 4);
          if (act && (tid & 7) == 0) atomicAdd(ssq + row, sq); }
        __syncthreads();
    }
    float* o = P.out + O_SSDP + (((size_t)(l * NPB + b) * 16 + h) * 64 + p) * 128 + ng * 16;
#pragma unroll
    for (int i = 0; i < 4; ++i) ((f32x4*)o)[i] = (f32x4){S[4 * i], S[4 * i + 1], S[4 * i + 2], S[4 * i + 3]};
}

constexpr int SRS = 136;
constexpr int SSD_CS = 0, SSD_BS = 34816, SSD_BT = 69632, SSD_XT = 104448, SSD_SS = 121856, SSD_SM = 139264, SSD_END = SSD_SM + 1536;
static_assert(SSD_END <= LDS_BYTES - 256, "SSD LDS map");
__device__ __forceinline__ unsigned cvtpk(float lo, float hi) { unsigned r; asm volatile("v_cvt_pk_bf16_f32 %0, %1, %2" : "=v"(r) : "v"(lo), "v"(hi)); return r; }
__device__ __forceinline__ void ssd_prompt_mfma(const Params& P, const Ctx& C, int l, int b, int h) {
    typedef pg8::bf16x8 bf16x8;
    const int tid = C.tid, lane = C.lane, w = C.wave, l15 = lane & 15, q = lane >> 4, g = h >> 3;
    LAS bf16* Cs = (LAS bf16*)(C.lds + SSD_CS); LAS bf16* Bs = (LAS bf16*)(C.lds + SSD_BS); LAS bf16* BT = (LAS bf16*)(C.lds + SSD_BT); LAS bf16* XT = (LAS bf16*)(C.lds + SSD_XT); LAS bf16* Ss = (LAS bf16*)(C.lds + SSD_SS);
    LAS float* dts = (LAS float*)(C.lds + SSD_SM); LAS float* cums = dts + 128; LAS int* rws = (LAS int*)(cums + 128);
    const float a = -expf(P.in[I_ALOG][l * 16 + h]), Dh = P.in[I_SSDD][l * 16 + h];
    const bf16* xbcc = WSP(bf16, WS_XBCC); const bf16* proj = WSP(bf16, WS_PROJ); bf16* ymix = WSP(bf16, WS_YMIX); const float* dtg = WSP(float, WS_DT);
    float* ssq = WSP(float, WS_CTL) + CW_SSQ + (size_t)(l + C.sslot) * MP;
    f32x4 S[4];
#pragma unroll
    for (int pt = 0; pt < 4; ++pt) S[pt] = (f32x4){0.f, 0.f, 0.f, 0.f};
    for (int i = tid; i < 64 * SRS * 2 / 16; i += NTHR) ((LAS v4u*)Ss)[i] = (v4u){0u, 0u, 0u, 0u};
#pragma unroll 1
    for (int ci = 0; ci < 17; ++ci) {
        const int tt0 = ci == 0 ? 0 : NMETA + 128 * (ci - 1), nvalid = ci == 0 ? NMETA : 128;
        { const int j = tid >> 2, part = tid & 3, jj = j < nvalid ? j : nvalid - 1; const bf16* src = xbcc + (size_t)prow(b, tt0 + jj) * XBCW;
#pragma unroll
          for (int e = 0; e < 4; ++e) { *(LAS v4u*)(Cs + j * SRS + part * 32 + 8 * e) = *(const v4u*)(src + 1280 + g * 128 + part * 32 + 8 * e); *(LAS v4u*)(Bs + j * SRS + part * 32 + 8 * e) = *(const v4u*)(src + 1024 + g * 128 + part * 32 + 8 * e); }
          const v4u x0 = *(const v4u*)(src + h * 64 + part * 16), x1 = *(const v4u*)(src + h * 64 + part * 16 + 8);
          LAS bf16* xt = XT + (part * 16) * SRS + j;
          xt[0 * SRS] = (bf16)(x0.x & 0xffffu); xt[1 * SRS] = (bf16)(x0.x >> 16); xt[2 * SRS] = (bf16)(x0.y & 0xffffu); xt[3 * SRS] = (bf16)(x0.y >> 16); xt[4 * SRS] = (bf16)(x0.z & 0xffffu); xt[5 * SRS] = (bf16)(x0.z >> 16); xt[6 * SRS] = (bf16)(x0.w & 0xffffu); xt[7 * SRS] = (bf16)(x0.w >> 16);
          xt[8 * SRS] = (bf16)(x1.x & 0xffffu); xt[9 * SRS] = (bf16)(x1.x >> 16); xt[10 * SRS] = (bf16)(x1.y & 0xffffu); xt[11 * SRS] = (bf16)(x1.y >> 16); xt[12 * SRS] = (bf16)(x1.z & 0xffffu); xt[13 * SRS] = (bf16)(x1.z >> 16); xt[14 * SRS] = (bf16)(x1.w & 0xffffu); xt[15 * SRS] = (bf16)(x1.w >> 16); }
        if (w == 0) { const int j0 = 2 * lane, j1 = 2 * lane + 1; const int r0 = prow(b, tt0 + (j0 < nvalid ? j0 : nvalid - 1)), r1 = prow(b, tt0 + (j1 < nvalid ? j1 : nvalid - 1));
            const float d0 = j0 < nvalid ? dtg[(size_t)r0 * 16 + h] : 0.f, d1 = j1 < nvalid ? dtg[(size_t)r1 * 16 + h] : 0.f;
            float s = (d0 + d1) * a;
#pragma unroll
            for (int o = 1; o < 64; o <<= 1) { const float t = __shfl_up(s, o); if (lane >= o) s += t; }
            dts[j0] = d0; dts[j1] = d1; cums[j0] = s - d1 * a; cums[j1] = s; rws[j0] = r0; rws[j1] = r1; }
        __syncthreads();
        const float cl = cums[127];
        { const int j = tid >> 2, part = tid & 3; const float wj = __expf(cl - cums[j]) * dts[j];
#pragma unroll
          for (int e = 0; e < 4; ++e) { const v4u bv = *(const LAS v4u*)(Bs + j * SRS + part * 32 + 8 * e); LAS bf16* bt = BT + (part * 32 + 8 * e) * SRS + j;
              bt[0 * SRS] = (bf16)f2bf(bflo(bv.x) * wj); bt[1 * SRS] = (bf16)f2bf(bfhi(bv.x) * wj); bt[2 * SRS] = (bf16)f2bf(bflo(bv.y) * wj); bt[3 * SRS] = (bf16)f2bf(bfhi(bv.y) * wj);
              bt[4 * SRS] = (bf16)f2bf(bflo(bv.z) * wj); bt[5 * SRS] = (bf16)f2bf(bfhi(bv.z) * wj); bt[6 * SRS] = (bf16)f2bf(bflo(bv.w) * wj); bt[7 * SRS] = (bf16)f2bf(bfhi(bv.w) * wj); } }
        bf16x8 Cf[4];
#pragma unroll
        for (int ks = 0; ks < 4; ++ks) Cf[ks] = *(const LAS bf16x8*)(Cs + (16 * w + l15) * SRS + ks * 32 + 8 * q);
        f32x4 G[8];
#pragma unroll
        for (int jb = 0; jb < 8; ++jb) { G[jb] = (f32x4){0.f, 0.f, 0.f, 0.f};
            if (jb <= w) {
#pragma unroll
                for (int ks = 0; ks < 4; ++ks) { const bf16x8 af = *(const LAS bf16x8*)(Bs + (16 * jb + l15) * SRS + ks * 32 + 8 * q); G[jb] = __builtin_amdgcn_mfma_f32_16x16x32_bf16(af, Cf[ks], G[jb], 0, 0, 0); } } }
        __syncthreads();
        const int irow = 16 * w + l15; const float cumi = cums[irow];
        LAS bf16* Ps = Bs;
#pragma unroll
        for (int jb = 0; jb < 8; ++jb) {
            if (jb <= w) { float pv[4];
#pragma unroll
                for (int r = 0; r < 4; ++r) { const int j = 16 * jb + 4 * q + r; const float e = __expf(cumi - cums[j]) * dts[j]; pv[r] = (j <= irow) ? G[jb][r] * e : 0.f; }
                *(LAS v2u*)(Ps + irow * SRS + 16 * jb + 4 * q) = (v2u){cvtpk(pv[0], pv[1]), cvtpk(pv[2], pv[3])}; }
            else if (jb == w + 1) *(LAS v2u*)(Ps + irow * SRS + 16 * jb + 4 * q) = (v2u){0u, 0u};
        }
        f32x4 Y2[4], Y3[4];
#pragma unroll
        for (int pt = 0; pt < 4; ++pt) { Y2[pt] = (f32x4){0.f, 0.f, 0.f, 0.f}; Y3[pt] = (f32x4){0.f, 0.f, 0.f, 0.f}; }
#pragma unroll
        for (int ks = 0; ks < 4; ++ks) {
            if (ks <= (w >> 1)) { const bf16x8 pf = *(const LAS bf16x8*)(Ps + irow * SRS + ks * 32 + 8 * q);
#pragma unroll
                for (int pt = 0; pt < 4; ++pt) { const bf16x8 xf = *(const LAS bf16x8*)(XT + (16 * pt + l15) * SRS + ks * 32 + 8 * q); Y2[pt] = __builtin_amdgcn_mfma_f32_16x16x32_bf16(xf, pf, Y2[pt], 0, 0, 0); } }
#pragma unroll
            for (int pt = 0; pt < 4; ++pt) { const bf16x8 sf = *(const LAS bf16x8*)(Ss + (16 * pt + l15) * SRS + ks * 32 + 8 * q); Y3[pt] = __builtin_amdgcn_mfma_f32_16x16x32_bf16(sf, Cf[ks], Y3[pt], 0, 0, 0); }
        }
        { const float ecum = __expf(cumi); const int row = rws[irow]; const bool valid = (ci > 0) || (irow < NMETA && b == 0); float sq = 0.f;
#pragma unroll
          for (int pt = 0; pt < 4; ++pt) { const int pc = h * 64 + 16 * pt + 4 * q;
              const v2u xv = *(const v2u*)(xbcc + (size_t)row * XBCW + pc), zv = *(const v2u*)(proj + (size_t)row * NIN + PZ + pc);
              const float y0 = (Y2[pt][0] + ecum * Y3[pt][0] + Dh * bflo(xv.x)) * silu_f(bflo(zv.x)), y1 = (Y2[pt][1] + ecum * Y3[pt][1] + Dh * bfhi(xv.x)) * silu_f(bfhi(zv.x));
              const float y2 = (Y2[pt][2] + ecum * Y3[pt][2] + Dh * bflo(xv.y)) * silu_f(bflo(zv.y)), y3 = (Y2[pt][3] + ecum * Y3[pt][3] + Dh * bfhi(xv.y)) * silu_f(bfhi(zv.y));
              sq += (y0 * y0 + y1 * y1) + (y2 * y2 + y3 * y3);
              if (valid) *(v2u*)(ymix + (size_t)row * DMIX + pc) = (v2u){cvtpk(y0, y1), cvtpk(y2, y3)}; }
          sq += __shfl_xor(sq, 16); sq += __shfl_xor(sq, 32);
          if (valid && q == 0) atomicAdd(ssq + row, sq); }
        __syncthreads();
        { const float dec = __expf(cl);
#pragma unroll
          for (int pt = 0; pt < 4; ++pt) S[pt] = S[pt] * dec;
#pragma unroll
          for (int ks = 0; ks < 4; ++ks) { const bf16x8 bf = *(const LAS bf16x8*)(BT + (16 * w + l15) * SRS + ks * 32 + 8 * q);
#pragma unroll
              for (int pt = 0; pt < 4; ++pt) { const bf16x8 xf = *(const LAS bf16x8*)(XT + (16 * pt + l15) * SRS + ks * 32 + 8 * q); S[pt] = __builtin_amdgcn_mfma_f32_16x16x32_bf16(bf, xf, S[pt], 0, 0, 0); } }
#pragma unroll
          for (int pt = 0; pt < 4; ++pt) *(LAS v2u*)(Ss + (16 * pt + l15) * SRS + 16 * w + 4 * q) = (v2u){cvtpk(S[pt][0], S[pt][1]), cvtpk(S[pt][2], S[pt][3])}; }
        __syncthreads();
    }
#pragma unroll
    for (int pt = 0; pt < 4; ++pt) *(f32x4*)(P.out + O_SSDP + (((size_t)(l * NPB + b) * 16 + h) * 64 + 16 * pt + l15) * 128 + 16 * w + 4 * q) = S[pt];
}

__device__ __forceinline__ void ssd_sample_item(const Params& P, const Ctx& C, int l, int b, int h) {
    const int t2 = C.tid & 255, p = t2 >> 2, nq = t2 & 3, g = h >> 3;
    const float a = -expf(P.in[I_ALOG][l * 16 + h]), Dh = P.in[I_SSDD][l * 16 + h];
    const size_t soff = (((size_t)(l * NSB + b) * 16 + h) * 64 + p) * 128 + nq * 32;
    const float* sp = P.in[I_SSD] + soff;
    f32x4 S[8];
#pragma unroll
    for (int i = 0; i < 8; ++i) S[i] = ((const f32x4*)sp)[i];
    float* ssq = (WSP(float, WS_CTL) + CW_SSQ) + (size_t)(l + C.sslot) * MP;
#pragma unroll 1
    for (int s = 0; s < 4; ++s) {
        const int row = ROW_S + 4 * b + s; const bf16* src = WSP(bf16, WS_XBCC) + (size_t)row * XBCW;
        const float dt = WSP(float, WS_DT)[(size_t)row * 16 + h], dA = __expf(dt * a), x = bf2f(src[h * 64 + p]), dtx = dt * x;
        float acc = 0.f;
#pragma unroll
        for (int i = 0; i < 4; ++i) { const v4u bw = *(const v4u*)(src + 1024 + g * 128 + nq * 32 + 8 * i), cwv = *(const v4u*)(src + 1280 + g * 128 + nq * 32 + 8 * i);
            f32x4 s0 = S[2 * i], s1 = S[2 * i + 1];
            s0.x = dA * s0.x + dtx * bflo(bw.x); acc += s0.x * bflo(cwv.x); s0.y = dA * s0.y + dtx * bfhi(bw.x); acc += s0.y * bfhi(cwv.x);
            s0.z = dA * s0.z + dtx * bflo(bw.y); acc += s0.z * bflo(cwv.y); s0.w = dA * s0.w + dtx * bfhi(bw.y); acc += s0.w * bfhi(cwv.y);
            s1.x = dA * s1.x + dtx * bflo(bw.z); acc += s1.x * bflo(cwv.z); s1.y = dA * s1.y + dtx * bfhi(bw.z); acc += s1.y * bfhi(cwv.z);
            s1.z = dA * s1.z + dtx * bflo(bw.w); acc += s1.z * bflo(cwv.w); s1.w = dA * s1.w + dtx * bfhi(bw.w); acc += s1.w * bfhi(cwv.w);
            S[2 * i] = s0; S[2 * i + 1] = s1; }
        acc += __shfl_xor(acc, 1); acc += __shfl_xor(acc, 2);
        const float z = bf2f(WSP(bf16, WS_PROJ)[(size_t)row * NIN + PZ + h * 64 + p]);
        const float y = (acc + Dh * x) * silu_f(z);
        float sq = (nq == 0) ? y * y : 0.f;
        if (nq == 0) WSP(bf16, WS_YMIX)[(size_t)row * DMIX + h * 64 + p] = (bf16)f2bf(y);
        sq = wave_sum(sq);
        if (C.lane == 0) atomicAdd(ssq + row, sq);
    }
    float* o = P.out + O_SSDS + soff;
#pragma unroll
    for (int i = 0; i < 8; ++i) ((f32x4*)o)[i] = S[i];
}

constexpr int LR_XR = 0, LR_GT = 16896, LR_XCB = 33280, LR_XC32 = 51712, LR_AV = 84480, LR_WA = 117248, LR_WX = 126464, LR_SA = 135680, LR_SB = 137728, LR_CST = 139776, LR_END = 140544, LRS = 72;
static_assert(LR_END <= LDS_BYTES - 256, "LRU LDS map");
template <bool SAMPLE> __device__ __forceinline__ void lru_item(const Params& P, const Ctx& C, int l, int sq, int k) {
    typedef pg8::bf16x8 bf16x8;
    const int tid = C.tid, lane = C.lane, c = tid & 63, w = C.wave, ch = k * 64 + c, l15 = lane & 15, q = lane >> 4;
    LAS bf16* XR = (LAS bf16*)(C.lds + LR_XR); LAS bf16* GT = (LAS bf16*)(C.lds + LR_GT); LAS bf16* XCb = (LAS bf16*)(C.lds + LR_XCB); LAS float* XC = (LAS float*)(C.lds + LR_XC32); LAS float* AV = (LAS float*)(C.lds + LR_AV);
    LAS float* BV = XC; LAS bf16* WaT = (LAS bf16*)(C.lds + LR_WA); LAS bf16* WxT = (LAS bf16*)(C.lds + LR_WX); LAS float* SA = (LAS float*)(C.lds + LR_SA); LAS float* SB = (LAS float*)(C.lds + LR_SB); LAS float* CST = (LAS float*)(C.lds + LR_CST);
    const bf16* proj = WSP(bf16, WS_PROJ); bf16* ymix = WSP(bf16, WS_YMIX);
    { const float* pa = P.in[I_LWA] + (size_t)(l * 16 + k) * 4096; const float* px = P.in[I_LWX] + (size_t)(l * 16 + k) * 4096;
#pragma unroll
      for (int e = 0; e < 8; ++e) { const int i = (tid >> 6) + 8 * e; WaT[c * LRS + i] = (bf16)f2bf(pa[i * 64 + c]); WxT[c * LRS + i] = (bf16)f2bf(px[i * 64 + c]); }
      if (tid < 64) { CST[c] = P.in[I_LBA][l * D + ch]; CST[64 + c] = P.in[I_LBX][l * D + ch]; CST[128 + c] = softplus_f(-P.in[I_LLAM][l * D + ch]); } }
    const float cb = P.in[I_LCONVB][l * D + ch];
    float cwk[4];
#pragma unroll
    for (int kk = 0; kk < 4; ++kk) cwk[kk] = P.in[I_LCONVW][(size_t)(l * 4 + kk) * D + ch];
    float carry = 0.f;
    const int nch = SAMPLE ? 1 : 17;
#pragma unroll 1
    for (int ci = 0; ci < nch; ++ci) {
        const int tt0 = SAMPLE ? 0 : (ci == 0 ? 0 : NMETA + 128 * (ci - 1)), nvalid = (SAMPLE || ci > 0) ? 128 : NMETA;
        for (int pi = tid; pi < 131 * 8; pi += NTHR) { const int rr = pi >> 3, cp = pi & 7; v4u v = (v4u){0u, 0u, 0u, 0u};
            if (SAMPLE) { if (rr >= 3) v = *(const v4u*)(proj + (size_t)(ROW_S + 128 * sq + rr - 3) * NIN + PXR + k * 64 + cp * 8); }
            else { const int tp = tt0 - 3 + rr; if (tp >= 0 && rr - 3 < nvalid) v = *(const v4u*)(proj + (size_t)prow(sq, tp) * NIN + PXR + k * 64 + cp * 8); }
            *(LAS v4u*)(XR + rr * 64 + cp * 8) = v; }
        for (int pi = tid; pi < 128 * 8; pi += NTHR) { const int rr = pi >> 3, cp = pi & 7; v4u v = (v4u){0u, 0u, 0u, 0u};
            if (SAMPLE) v = *(const v4u*)(proj + (size_t)(ROW_S + 128 * sq + rr) * NIN + PGATE + k * 64 + cp * 8);
            else if (rr < nvalid) v = *(const v4u*)(proj + (size_t)prow(sq, tt0 + rr) * NIN + PGATE + k * 64 + cp * 8);
            *(LAS v4u*)(GT + rr * 64 + cp * 8) = v; }
        __syncthreads();
#pragma unroll 4
        for (int j = 0; j < 16; ++j) { const int t = 16 * w + j; float acc = cb;
            if (SAMPLE) { const int bb = 32 * sq + (t >> 2), s = t & 3;
#pragma unroll
                for (int kk = 0; kk < 4; ++kk) { const int pos = s - 3 + kk;
                    const float v = pos >= 0 ? bf2f(XR[(t - s + pos + 3) * 64 + c]) : P.in[I_LRUCONV][((size_t)(l * NSB + bb) * 3 + (3 + pos)) * D + ch];
                    acc += cwk[kk] * v; } }
            else {
#pragma unroll
                for (int kk = 0; kk < 4; ++kk) acc += cwk[kk] * bf2f(XR[(t + kk) * 64 + c]); }
            XC[t * 64 + c] = acc; XCb[t * LRS + c] = (bf16)f2bf(acc); }
        __syncthreads();
        { const int t = 16 * w + l15;
          const bf16x8 xf0 = *(const LAS bf16x8*)(XCb + t * LRS + 8 * q), xf1 = *(const LAS bf16x8*)(XCb + t * LRS + 32 + 8 * q);
#pragma unroll
          for (int ct = 0; ct < 4; ++ct) { const int c0 = 16 * ct + 4 * q;
              f32x4 R = (f32x4){0.f, 0.f, 0.f, 0.f}, I = (f32x4){0.f, 0.f, 0.f, 0.f};
              R = __builtin_amdgcn_mfma_f32_16x16x32_bf16(*(const LAS bf16x8*)(WaT + (16 * ct + l15) * LRS + 8 * q), xf0, R, 0, 0, 0);
              R = __builtin_amdgcn_mfma_f32_16x16x32_bf16(*(const LAS bf16x8*)(WaT + (16 * ct + l15) * LRS + 32 + 8 * q), xf1, R, 0, 0, 0);
              I = __builtin_amdgcn_mfma_f32_16x16x32_bf16(*(const LAS bf16x8*)(WxT + (16 * ct + l15) * LRS + 8 * q), xf0, I, 0, 0, 0);
              I = __builtin_amdgcn_mfma_f32_16x16x32_bf16(*(const LAS bf16x8*)(WxT + (16 * ct + l15) * LRS + 32 + 8 * q), xf1, I, 0, 0, 0);
              const f32x4 vba = *(const LAS f32x4*)(CST + c0), vbx = *(const LAS f32x4*)(CST + 64 + c0), vsp = *(const LAS f32x4*)(CST + 128 + c0), xc4 = *(const LAS f32x4*)(XC + t * 64 + c0);
              f32x4 h0 = (f32x4){0.f, 0.f, 0.f, 0.f};
              if (SAMPLE) { if ((t & 3) == 0) h0 = *(const f32x4*)(P.in[I_LRU] + (size_t)(l * NSB + 32 * sq + (t >> 2)) * D + k * 64 + c0); }
              f32x4 a4, b4;
#pragma unroll
              for (int r = 0; r < 4; ++r) { const float la = -8.0f * sigmoid_f(R[r] + vba[r]) * vsp[r]; float a = __expf(la); float bt = sqrtf(-expm1f(2.0f * la)) * sigmoid_f(I[r] + vbx[r]) * xc4[r];
                  if (SAMPLE) { if ((t & 3) == 0) { bt += a * h0[r]; a = 0.f; } }
                  else { if (t >= nvalid) { a = 1.f; bt = 0.f; } }
                  a4[r] = a; b4[r] = bt; }
              *(LAS f32x4*)(AV + t * 64 + c0) = a4; *(LAS f32x4*)(BV + t * 64 + c0) = b4; } }
        __syncthreads();
        float Ap = 1.f, hl = 0.f;
#pragma unroll
        for (int j = 0; j < 16; ++j) { const int t = 16 * w + j; const float a = AV[t * 64 + c]; hl = a * hl + BV[t * 64 + c]; Ap *= a; }
        SA[w * 64 + c] = Ap; SB[w * 64 + c] = hl;
        __syncthreads();
        float hin = carry, tot = carry;
#pragma unroll
        for (int w2 = 0; w2 < 8; ++w2) { const float A2 = SA[w2 * 64 + c], B2 = SB[w2 * 64 + c]; tot = A2 * tot + B2; if (w2 < w) hin = A2 * hin + B2; }
        float hc = hin;
#pragma unroll 4
        for (int j = 0; j < 16; ++j) { const int t = 16 * w + j; hc = AV[t * 64 + c] * hc + BV[t * 64 + c];
            int row; bool wr_;
            if (SAMPLE) { row = ROW_S + 128 * sq + t; wr_ = true; if ((t & 3) == 3) P.out[O_LRUS + (size_t)(l * NSB + 32 * sq + (t >> 2)) * D + ch] = hc; }
            else { row = prow(sq, tt0 + (t < nvalid ? t : nvalid - 1)); wr_ = ci > 0 || (t < NMETA && sq == 0); }
            if (wr_) ymix[(size_t)row * DMIX + D + ch] = (bf16)f2bf(hc * gelu_tanh_f(bf2f(GT[t * 64 + c]))); }
        carry = tot;
        __syncthreads();
    }
    if (!SAMPLE && w == 0) P.out[O_LRUP + (size_t)(l * NPB + sq) * D + ch] = carry;
}

__device__ __forceinline__ void mixer_phase(const Params& P, const Ctx& C, int l) {
    const int bx = blockIdx.x;
#if SSD_NAIVE
    if (bx < 128) ssd_prompt_naive(P, C, l, bx >> 4, bx & 15);
#else
    if (bx < 128) ssd_prompt_mfma(P, C, l, bx >> 4, bx & 15);
#endif
    else if (bx < 256) lru_item<false>(P, C, l, (bx - 128) >> 4, (bx - 128) & 15);
    if (bx < 64) lru_item<true>(P, C, l, bx >> 4, bx & 15);
    for (int it = bx; it < NSB * 16 / 2; it += 256) { const int id = it * 2 + (C.tid >> 8); ssd_sample_item(P, C, l, id >> 4, id & 15); }
}

__device__ __forceinline__ void ynorm_phase(const Params& P, const Ctx& C, int l) {
    const float* ssq = (WSP(float, WS_CTL) + CW_SSQ) + (size_t)l * MP;
    for (int r = C.gw; r < NROWS; r += C.NGW) {
        const float rs = rsqrtf(ssq[r] * (1.f / D) + EPS);
        v4u* p = (v4u*)(WSP(bf16, WS_YMIX) + (size_t)r * DMIX) + 2 * C.lane;
#pragma unroll
        for (int i = 0; i < 2; ++i) { v4u w = p[i];
            w.x = pk2(bflo(w.x) * rs, bfhi(w.x) * rs); w.y = pk2(bflo(w.y) * rs, bfhi(w.y) * rs); w.z = pk2(bflo(w.z) * rs, bfhi(w.z) * rs); w.w = pk2(bflo(w.w) * rs, bfhi(w.w) * rs);
            p[i] = w; }
    }
}

constexpr int NPHASE = 1 + 12 * DEPTH;
__global__ void __launch_bounds__(NTHR, 2) hymba_fwd(Params P) {
    extern __shared__ __attribute__((aligned(16))) unsigned char lds_raw[];
    Ctx C;
    C.lds = (LAS unsigned char*)lds_raw;
    C.tid = threadIdx.x; C.lane = C.tid & 63; C.wave = __builtin_amdgcn_readfirstlane(C.tid >> 6);
    C.sslot = 0; C.G = gridDim.x; C.gw = blockIdx.x * NWAVES + C.wave; C.NGW = C.G * NWAVES;
    unsigned char* ws = P.ws;
    volatile LAS unsigned* MISC = (volatile LAS unsigned*)(C.lds + MISC_OFF);
    for (int u = C.tid; u < 32; u += NTHR) ((LAS unsigned*)(C.lds + MISC_OFF))[u] = 0u;
    __syncthreads();
#if MEGA
    XcdBarrier bar = xcd_barrier_post((unsigned*)(ws + WS_CTL) + CW_BAR, MISC + 8);
#endif
    const int lo = P.ph_lo, hi = P.ph_hi;
#define IN(k) (lo <= (k) && (k) < hi)
#if MEGA
#define SEAM(k) do { if (IN(k) && IN((k) + 1)) xcd_barrier(bar); } while (0)
#else
#define SEAM(k) do { } while (0)
#endif
#define GEMM_PHASE(Aop, Btop, Nn, Kk, kind, perm, outp, ldo) do { pg8::Gemm g{Aop, Btop, MP, Nn, Kk}; pg8::StaticOrder S; S.init(MP, Nn, C.G, (int)blockIdx.x); \
        pg8::EpiAny E{kind, perm, outp, ldo}; pg8::gemm_phase<pg8::EpiAny, pg8::StaticOrder, true, true>(C.lds, g, S, E); } while (0)
    if (IN(0)) p0_prologue(P, C);
#if MEGA
    if (IN(0) && IN(1)) { VM_WAIT(); __syncthreads(); cg::this_grid().sync(); }
#endif
#if defined(PROBE_MIXER2)
#define PROBE_DUP_MIXER(l) do { if (IN(b0 + 5)) { C.sslot = 2; mixer_phase(P, C, (l)); C.sslot = 0; xcd_barrier(bar); } } while (0)
#else
#define PROBE_DUP_MIXER(l) do { } while (0)
#endif
#define LAYER(l) do { constexpr int b0 = 1 + 12 * (l); \
    if (IN(b0 + 0)) GEMM_PHASE(WSP(bf16, WS_XB), WSP(bf16, WS_WGU1) + (size_t)(l) * NGU * D, NGU, D, 2, false, WSP(bf16, WS_H), DFF); SEAM(b0 + 0); \
    if (IN(b0 + 1)) GEMM_PHASE(WSP(bf16, WS_H), WSP(bf16, WS_WD1) + (size_t)(l) * D * DFF, D, DFF, 0, false, WSP(float, WS_Y), D); SEAM(b0 + 1); \
    if (IN(b0 + 2)) rn_phase(P, C, 0.5f, P.in[I_F1POST] + (l) * D, true, (l), false); SEAM(b0 + 2); \
    if (IN(b0 + 3)) GEMM_PHASE(WSP(bf16, WS_XB), WSP(bf16, WS_WIN) + (size_t)(l) * NIN * D, NIN, D, 1, true, WSP(bf16, WS_PROJ), NIN); SEAM(b0 + 3); \
    if (IN(b0 + 4)) conv_phase(P, C, (l)); SEAM(b0 + 4); \
    PROBE_DUP_MIXER(l); if (IN(b0 + 5)) mixer_phase(P, C, (l)); SEAM(b0 + 5); \
    if (IN(b0 + 6)) ynorm_phase(P, C, (l)); SEAM(b0 + 6); \
    if (IN(b0 + 7)) GEMM_PHASE(WSP(bf16, WS_YMIX), WSP(bf16, WS_WOUT) + (size_t)(l) * D * DMIX, D, DMIX, 0, false, WSP(float, WS_Y), D); SEAM(b0 + 7); \
    if (IN(b0 + 8)) rn_phase(P, C, 1.0f, P.in[I_MPOST] + (l) * D, false, (l), false); SEAM(b0 + 8); \
    if (IN(b0 + 9)) GEMM_PHASE(WSP(bf16, WS_XB), WSP(bf16, WS_WGU2) + (size_t)(l) * NGU * D, NGU, D, 2, false, WSP(bf16, WS_H), DFF); SEAM(b0 + 9); \
    if (IN(b0 + 10)) GEMM_PHASE(WSP(bf16, WS_H), WSP(bf16, WS_WD2) + (size_t)(l) * D * DFF, D, DFF, 0, false, WSP(float, WS_Y), D); SEAM(b0 + 10); \
    if (IN(b0 + 11)) rn_phase(P, C, 0.5f, P.in[I_F2POST] + (l) * D, false, (l), (l) == DEPTH - 1); SEAM(b0 + 11); } while (0)
    LAYER(0);
    LAYER(1);
}

extern "C" void kernel_launch(void* const* d_in, const int* in_sizes, int n_in, void* d_out, int out_size, void* d_ws, size_t ws_size, hipStream_t stream) {
    static int grid = 0;
    if (grid == 0) {
        if (n_in != N_IN || out_size != (int)O_END || ws_size < WS_END) { fprintf(stderr, "kernel_launch: built for %d inputs, %zu outputs, >= %zu bytes of workspace; got n_in %d, out %d, ws %zu; nothing launched\n", (int)N_IN, (size_t)O_END, (size_t)WS_END, n_in, out_size, ws_size); grid = -1; return; }
        int dev = 0, cus = 0, per_cu = 0;
        if (hipGetDevice(&dev) != hipSuccess || hipDeviceGetAttribute(&cus, hipDeviceAttributeMultiprocessorCount, dev) != hipSuccess) { fprintf(stderr, "kernel_launch: device query failed\n"); grid = -1; return; }
        if (hipFuncSetAttribute((const void*)hymba_fwd, hipFuncAttributeMaxDynamicSharedMemorySize, LDS_BYTES) != hipSuccess) { fprintf(stderr, "kernel_launch: hipFuncSetAttribute failed\n"); grid = -1; return; }
        if (hipOccupancyMaxActiveBlocksPerMultiprocessor(&per_cu, (const void*)hymba_fwd, NTHR, LDS_BYTES) != hipSuccess || per_cu < 1) { fprintf(stderr, "kernel_launch: occupancy query says %d blocks per CU\n", per_cu); grid = -1; return; }
        (void)hipGetLastError();
        grid = cus * per_cu; if (grid > 256) grid = 256;
        if (grid != 256) { fprintf(stderr, "kernel_launch: this kernel needs a 256-workgroup resident grid (got %d CUs x %d)\n", cus, per_cu); grid = -1; return; }
    }
    if (grid < 0) return;
    if (hipMemsetAsync((char*)d_ws + WS_CTL, 0, CTL_ZERO_BYTES, stream) != hipSuccess) { fprintf(stderr, "kernel_launch: hipMemsetAsync failed\n"); return; }
    Params a{};
    for (int i = 0; i < N_IN; ++i) a.in[i] = (const float*)d_in[i];
    a.out = (float*)d_out; a.ws = (unsigned char*)d_ws;
#if MEGA
    a.ph_lo = 0; a.ph_hi = NPHASE;
    void* args[] = {&a};
    hipError_t e = hipLaunchCooperativeKernel((const void*)hymba_fwd, dim3(grid), dim3(NTHR), args, LDS_BYTES, stream);
    if (e != hipSuccess) fprintf(stderr, "kernel_launch: cooperative launch failed: %s (grid %d)\n", hipGetErrorString(e), grid);
#else
    for (int ph = 0; ph < NPHASE; ++ph) { a.ph_lo = ph; a.ph_hi = ph + 1; hipLaunchKernelGGL(hymba_fwd, dim3(grid), dim3(NTHR), LDS_BYTES, stream, a); }
#endif
}
```
